# Optimizing an MI355X kernel written in HIP

```python
import jax, jax.numpy as jnp
from jax import lax
import numpy as np

D_MODEL = 1024
BATCH = 1
SEQ = 16384
DEPTH = 4

GRID_W = 64
CTX_LEN = 256
D_MIX = D_MODEL
HEAD_DIM = 64
POOL_GROUPS = 4
POOL_WINDOWS = (2, 4, 8, 16)
POOL_DIM = D_MIX // 4
POOL_GROUP_DIM = POOL_DIM // POOL_GROUPS
NA_HEADS = (D_MIX - POOL_DIM) // 2 // HEAD_DIM
NA_DIM = NA_HEADS * HEAD_DIM
NA_KH = 8
NA_KW = 16
RET_HEADS = (D_MIX - POOL_DIM - NA_DIM) // HEAD_DIM
RET_DIM = RET_HEADS * HEAD_DIM
RET_CHUNK = 128
D_FF = 2816
CONV_W = 3
ROPE_BASE = 10000.0
ROT_QUARTER = HEAD_DIM // 4
EPS = 1e-6
NEG_INF = -1e30
IN_SIZES = (POOL_DIM, NA_DIM, NA_DIM, NA_DIM, RET_DIM, RET_DIM, RET_DIM, RET_DIM)
IN_DIM = sum(IN_SIZES)
SPLIT_POINTS = tuple(int(s) for s in np.cumsum(IN_SIZES)[:-1])

kernel_name = "hybrid_pool_na_retention_dit"


def rmsnorm(t, g):
    tf = t.astype(jnp.float32)
    y = tf * lax.rsqrt(jnp.mean(tf * tf, axis=-1, keepdims=True) + EPS) * g.astype(jnp.float32)
    return y.astype(t.dtype)


def modulate(t, shift, scale):
    return t * (1 + scale) + shift


def heads(t, n):
    return t.reshape(t.shape[0], t.shape[1], n, HEAD_DIM)


def pool_mixer(p, w_grp, scale):
    B, L, _ = p.shape
    pf = p.astype(jnp.float32).reshape(B, L, POOL_GROUPS, POOL_GROUP_DIM)
    csum = jnp.concatenate([jnp.zeros_like(pf[:, :1]), jnp.cumsum(pf, axis=1)], axis=1)
    t = jnp.arange(L)[:, None]
    win = jnp.asarray(POOL_WINDOWS, dtype=jnp.int32)[None, :]
    lo = jnp.clip(t - win // 2, 0, L)
    hi = jnp.clip(t - win // 2 + win, 0, L)
    g = jnp.arange(POOL_GROUPS)[None, :]
    total = csum[:, hi, g] - csum[:, lo, g]
    mean = total / (hi - lo).astype(jnp.float32)[None, :, :, None]
    y = jnp.einsum('blgc,gcd->blgd', mean - pf, w_grp.astype(jnp.float32))
    return (y.reshape(B, L, POOL_DIM) * scale.astype(jnp.float32)).astype(p.dtype)


def neighborhood_attention(q, k, v, kc, vc, rpb, rows):
    B, L, H, dh = q.shape
    kh = min(NA_KH, rows)
    span = 2 * NA_KW
    n_cb = GRID_W // NA_KW
    qg = (q * dh ** -0.5).reshape(B, rows, GRID_W, H, dh)
    kg = k.reshape(B, rows, GRID_W, H, dh)
    vg = v.reshape(B, rows, GRID_W, H, dh)
    qcol = np.arange(GRID_W).reshape(n_cb, NA_KW)
    win_start = np.clip(qcol - NA_KW // 2, 0, GRID_W - NA_KW)
    col_start = np.clip(np.arange(n_cb) * NA_KW - NA_KW // 2, 0, GRID_W - span)
    kcol = col_start[:, None] + np.arange(span)
    col_valid = (kcol[:, None, :] >= win_start[:, :, None]) & (kcol[:, None, :] < win_start[:, :, None] + NA_KW)
    dc_idx = np.clip(kcol[:, None, :] - qcol[:, :, None] + NA_KW - 1, 0, 2 * NA_KW - 2)
    rpb_c = rpb.astype(jnp.float32)[:, :, dc_idx]
    valid = jnp.asarray(col_valid)[:, :, None, :]

    def one_row(r):
        rs = jnp.clip(r - kh // 2, 0, rows - kh)
        qr = lax.dynamic_index_in_dim(qg, r, axis=1, keepdims=False)
        kr = lax.dynamic_slice_in_dim(kg, rs, kh, axis=1)
        vr = lax.dynamic_slice_in_dim(vg, rs, kh, axis=1)
        kb = kr[:, :, kcol]
        vb = vr[:, :, kcol]
        qb = qr.reshape(B, n_cb, NA_KW, H, dh)
        dr_idx = rs + jnp.arange(kh) - r + NA_KH - 1
        bias = rpb_c[:, dr_idx].transpose(0, 2, 3, 1, 4)
        s_loc = jnp.einsum('bnqhd,binshd->bhnqis', qb, kb).astype(jnp.float32)
        s_loc = jnp.where(valid, s_loc + bias, NEG_INF)
        s_ctx = jnp.einsum('bnqhd,bkhd->bhnqk', qb, kc).astype(jnp.float32)
        s = jnp.concatenate([s_loc.reshape(B, H, n_cb, NA_KW, kh * span), s_ctx], axis=-1)
        p = jax.nn.softmax(s, axis=-1).astype(v.dtype)
        p_loc = p[..., :kh * span].reshape(B, H, n_cb, NA_KW, kh, span)
        p_ctx = p[..., kh * span:]
        o = jnp.einsum('bhnqis,binshd->bnqhd', p_loc, vb) + jnp.einsum('bhnqk,bkhd->bnqhd', p_ctx, vc)
        return o.reshape(B, GRID_W, H, dh)

    out = lax.map(one_row, jnp.arange(rows))
    return out.transpose(1, 0, 2, 3, 4).reshape(B, L, H, dh)


def context_attention(q, k, v):
    s = jnp.einsum('bqhd,bkhd->bhqk', q * HEAD_DIM ** -0.5, k).astype(jnp.float32)
    p = jax.nn.softmax(s, axis=-1).astype(v.dtype)
    return jnp.einsum('bhqk,bkhd->bqhd', p, v)


def axial_rotary(t, cos_r, sin_r, cos_c, sin_c):
    def rot(u, cos, sin):
        u1, u2 = jnp.split(u, 2, axis=-1)
        cos = cos[None, :, None, :]
        sin = sin[None, :, None, :]
        return jnp.concatenate([u1 * cos - u2 * sin, u1 * sin + u2 * cos], axis=-1)
    tr, tc = jnp.split(t, 2, axis=-1)
    return jnp.concatenate([rot(tr, cos_r, sin_r), rot(tc, cos_c, sin_c)], axis=-1)


def retention_chunks(q, k, v, log_gamma, state, with_outputs):
    B, L, H, _ = q.shape
    n = L // RET_CHUNK
    lg = log_gamma.astype(jnp.float32)
    idx = jnp.arange(RET_CHUNK, dtype=jnp.float32)
    diff = idx[:, None] - idx[None, :]
    intra = jnp.exp(jnp.where(diff[None] >= 0, diff[None] * lg[:, None, None], -jnp.inf))
    q_dec = jnp.exp((idx + 1)[None, :] * lg[:, None])
    k_dec = jnp.exp((RET_CHUNK - 1 - idx)[None, :] * lg[:, None])
    c_dec = jnp.exp(RET_CHUNK * lg)

    def to_chunks(t):
        return t.reshape(B, n, RET_CHUNK, H, t.shape[-1]).transpose(1, 0, 3, 2, 4)

    def step(s, blk):
        qb, kb, vb = blk
        s_new = s * c_dec[None, :, None, None] + jnp.einsum('bhcd,bhce->bhde', kb * k_dec[None, :, :, None], vb)
        if not with_outputs:
            return s_new, None
        a = jnp.einsum('bhid,bhjd->bhij', qb, kb) * intra[None]
        y = jnp.einsum('bhij,bhje->bhie', a, vb) + jnp.einsum('bhid,bhde->bhie', qb, s) * q_dec[None, :, :, None]
        return s_new, y

    s_fin, ys = lax.scan(step, state, (to_chunks(q), to_chunks(k), to_chunks(v)))
    if not with_outputs:
        return None, s_fin
    return ys.transpose(1, 0, 3, 2, 4).reshape(B, L, H, v.shape[-1]), s_fin


def bidirectional_retention(q, k, v, qc, kc, vc, dec_f, dec_b, need_ctx):
    B = q.shape[0]
    s0 = jnp.zeros((B, RET_HEADS, HEAD_DIM, HEAD_DIM), jnp.float32)
    rev = lambda t: jnp.flip(t, axis=1)
    yc_f, s_f = retention_chunks(qc, kc, vc, dec_f, s0, need_ctx)
    yx_f, _ = retention_chunks(q, k, v, dec_f, s_f, True)
    yc_b, s_b = retention_chunks(rev(qc), rev(kc), rev(vc), dec_b, s0, need_ctx)
    yx_b, _ = retention_chunks(rev(q), rev(k), rev(v), dec_b, s_b, True)
    yc = yc_f + rev(yc_b) if need_ctx else None
    return yx_f + rev(yx_b), yc


def retention_output(y, gate, gn_g):
    B, L = y.shape[:2]
    mu = jnp.mean(y, axis=-1, keepdims=True)
    var = jnp.mean((y - mu) ** 2, axis=-1, keepdims=True)
    yn = ((y - mu) * lax.rsqrt(var + EPS)).reshape(B, L, RET_DIM) * gn_g.astype(jnp.float32)
    return (jax.nn.silu(gate.astype(jnp.float32)) * yn).astype(gate.dtype)


def mixing_layer(px, pc, pool_w, pool_scale, na_rpb, dec_f, dec_b, gn_g, rope, rows, need_ctx):
    B, L, _ = px.shape
    xs = jnp.split(px, SPLIT_POINTS, axis=-1)
    cs = jnp.split(pc, SPLIT_POINTS, axis=-1)
    f32 = jnp.float32
    pool_x = pool_mixer(xs[0], pool_w, pool_scale)
    na_q, na_k, na_v = [heads(t, NA_HEADS) for t in xs[1:4]]
    nc_q, nc_k, nc_v = [heads(t, NA_HEADS) for t in cs[1:4]]
    na_x = neighborhood_attention(na_q, na_k, na_v, nc_k, nc_v, na_rpb, rows).reshape(B, L, NA_DIM)
    rq = axial_rotary(heads(xs[4], RET_HEADS).astype(f32), *rope)
    rk = axial_rotary(heads(xs[5], RET_HEADS).astype(f32), *rope) * HEAD_DIM ** -0.5
    rv = heads(xs[6], RET_HEADS).astype(f32)
    cq = heads(cs[4], RET_HEADS).astype(f32)
    ck = heads(cs[5], RET_HEADS).astype(f32) * HEAD_DIM ** -0.5
    cv = heads(cs[6], RET_HEADS).astype(f32)
    ret_x, ret_c = bidirectional_retention(rq, rk, rv, cq, ck, cv, dec_f, dec_b, need_ctx)
    ret_x = retention_output(ret_x, xs[7], gn_g)
    yx = jnp.concatenate([pool_x, na_x.astype(px.dtype), ret_x.astype(px.dtype)], axis=-1)
    if not need_ctx:
        return yx, None
    pool_c = pool_mixer(cs[0], pool_w, pool_scale)
    na_c = context_attention(nc_q, nc_k, nc_v).reshape(B, pc.shape[1], NA_DIM)
    ret_c = retention_output(ret_c, cs[7], gn_g)
    yc = jnp.concatenate([pool_c, na_c.astype(pc.dtype), ret_c.astype(pc.dtype)], axis=-1)
    return yx, yc


def conv_ffn(h, w_up, conv_w, conv_b, w_down):
    u = h @ w_up
    up = jnp.pad(u, ((0, 0), (1, 1), (0, 0)))
    u = up[:, :-2] * conv_w[0] + up[:, 1:-1] * conv_w[1] + up[:, 2:] * conv_w[2] + conv_b
    a, b = jnp.split(u, 2, axis=-1)
    return (jax.nn.silu(a) * b) @ w_down


def setup_inputs(seed: int = 0) -> dict:
    key = jax.random.key(seed)
    ks = jax.random.split(key, 24)
    f32 = jnp.float32
    nrm = lambda k, shape, s: jax.random.normal(k, shape, f32) * s
    exps_f = 5.0 + jnp.arange(RET_HEADS, dtype=f32)[None, :] + 0.25 * jax.random.uniform(ks[11], (DEPTH, RET_HEADS), f32)
    exps_b = 5.0 + jnp.arange(RET_HEADS, dtype=f32)[None, :] + 0.25 * jax.random.uniform(ks[12], (DEPTH, RET_HEADS), f32)
    return {
        "x": nrm(ks[0], (BATCH, SEQ, D_MODEL), 1.0),
        "c": nrm(ks[1], (BATCH, D_MODEL), 1.0),
        "ctx": nrm(ks[2], (BATCH, CTX_LEN, D_MODEL), 1.0),
        "c_ctx": nrm(ks[3], (D_MODEL,), 1.0),
        "w_mod": nrm(ks[4], (DEPTH, D_MODEL, 6 * D_MODEL), 0.5 * D_MODEL ** -0.5),
        "b_mod": nrm(ks[5], (DEPTH, 6 * D_MODEL), 0.02),
        "norm1_g": 1.0 + nrm(ks[6], (DEPTH, D_MODEL), 0.02),
        "w_in": nrm(ks[7], (DEPTH, D_MODEL, IN_DIM), D_MODEL ** -0.5),
        "pool_w": nrm(ks[8], (DEPTH, POOL_GROUPS, POOL_GROUP_DIM, POOL_GROUP_DIM), POOL_GROUP_DIM ** -0.5),
        "pool_scale": 1.0 + nrm(ks[9], (DEPTH, POOL_DIM), 0.1),
        "na_rpb": nrm(ks[10], (DEPTH, NA_HEADS, 2 * NA_KH - 1, 2 * NA_KW - 1), 0.1),
        "ret_decay_fwd": jnp.log1p(-jnp.exp2(-exps_f)),
        "ret_decay_bwd": jnp.log1p(-jnp.exp2(-exps_b)),
        "ret_gn_g": 1.0 + nrm(ks[13], (DEPTH, RET_DIM), 0.02),
        "w_out": nrm(ks[14], (DEPTH, D_MIX, D_MODEL), D_MIX ** -0.5),
        "norm2_g": 1.0 + nrm(ks[15], (DEPTH, D_MODEL), 0.02),
        "w_up": nrm(ks[16], (DEPTH, D_MODEL, 2 * D_FF), D_MODEL ** -0.5),
        "conv_w": nrm(ks[17], (DEPTH, CONV_W, 2 * D_FF), CONV_W ** -0.5),
        "conv_b": nrm(ks[18], (DEPTH, 2 * D_FF), 0.02),
        "w_down": nrm(ks[19], (DEPTH, D_FF, D_MODEL), D_FF ** -0.5),
        "final_g": 1.0 + nrm(ks[20], (D_MODEL,), 0.02),
    }


def reference(x, c, ctx, c_ctx, w_mod, b_mod, norm1_g, w_in, pool_w, pool_scale, na_rpb, ret_decay_fwd, ret_decay_bwd, ret_gn_g, w_out, norm2_g, w_up, conv_w, conv_b, w_down, final_g):
    B, L, _ = x.shape
    rows = L // GRID_W
    pos = jnp.arange(L)
    inv = ROPE_BASE ** (-jnp.arange(ROT_QUARTER, dtype=jnp.float32) / ROT_QUARTER)
    ang_r = (pos // GRID_W).astype(jnp.float32)[:, None] * inv[None, :]
    ang_c = (pos % GRID_W).astype(jnp.float32)[:, None] * inv[None, :]
    rope = (jnp.cos(ang_r), jnp.sin(ang_r), jnp.cos(ang_c), jnp.sin(ang_c))
    silu_c = jax.nn.silu(c)[:, None, :]
    silu_cc = jax.nn.silu(c_ctx)
    h = x
    hc = ctx
    for l in range(DEPTH):
        need_ctx = l < DEPTH - 1
        mx = jnp.split(silu_c @ w_mod[l] + b_mod[l], 6, axis=-1)
        mc = jnp.split(silu_cc @ w_mod[l] + b_mod[l], 6, axis=-1)
        ax = modulate(rmsnorm(h, norm1_g[l]), mx[0], mx[1])
        ac = modulate(rmsnorm(hc, norm1_g[l]), mc[0], mc[1])
        yx, yc = mixing_layer(ax @ w_in[l], ac @ w_in[l], pool_w[l], pool_scale[l], na_rpb[l],
                              ret_decay_fwd[l], ret_decay_bwd[l], ret_gn_g[l], rope, rows, need_ctx)
        h = h + mx[2] * (yx @ w_out[l])
        h = h + mx[5] * conv_ffn(modulate(rmsnorm(h, norm2_g[l]), mx[3], mx[4]), w_up[l], conv_w[l], conv_b[l], w_down[l])
        if need_ctx:
            hc = hc + mc[2] * (yc @ w_out[l])
            hc = hc + mc[5] * conv_ffn(modulate(rmsnorm(hc, norm2_g[l]), mc[3], mc[4]), w_up[l], conv_w[l], conv_b[l], w_down[l])
    return rmsnorm(h, final_g)
```

```cpp
#include <hip/hip_runtime.h>
#include <hip/hip_cooperative_groups.h>
#include <cstdio>
#include <cstdint>
namespace cg = cooperative_groups;

#ifndef ONE_LAUNCH
#define ONE_LAUNCH 0
#endif

typedef unsigned short bf16_t;
typedef short bf16x8 __attribute__((ext_vector_type(8)));
typedef float f32x4 __attribute__((ext_vector_type(4)));

constexpr int D = 1024, LAT = 16384, NCTX = 256, MT = LAT + NCTX, DEPTH = 4;
constexpr int IN_DIM = 2944, DFF = 2816, NUP = 2 * DFF;
constexpr int NCHUNK = MT / 128;
constexpr int C_POOL = 0, C_NQ = 256, C_NK = 640, C_NV = 1024, C_RQ = 1408, C_RK = 1792, C_RV = 2176, C_GT = 2560;

constexpr size_t WT_IN = 0, WT_OUT = (size_t)IN_DIM * D, WT_UP = WT_OUT + (size_t)D * D, WT_DOWN = WT_UP + (size_t)NUP * D;
constexpr size_t WT_LAYER = WT_DOWN + (size_t)D * DFF;
constexpr size_t OFF_BAR = 0;
constexpr size_t OFF_WT = 16384;
constexpr size_t OFF_H = OFF_WT + WT_LAYER * 2 * DEPTH;
constexpr size_t OFF_AY = OFF_H + (size_t)MT * D * 4;
constexpr size_t OFF_P = OFF_AY + (size_t)MT * D * 2;
constexpr size_t OFF_NVT = OFF_P + (size_t)MT * IN_DIM * 2;
constexpr size_t OFF_RVT = OFF_NVT + (size_t)384 * MT * 2;
constexpr size_t OFF_RKF = OFF_RVT + (size_t)384 * MT * 2;
constexpr size_t OFF_RKB = OFF_RKF + (size_t)384 * MT * 2;
constexpr size_t OFF_US = OFF_RKB + (size_t)384 * MT * 2;
constexpr size_t OFF_MOD = OFF_US + (size_t)NCHUNK * 2 * 6 * 4096 * 4;
constexpr size_t OFF_ROPE = OFF_MOD + (size_t)DEPTH * 2 * 6 * D * 4;
constexpr size_t WS_END = OFF_ROPE + (size_t)256 * 16 * 2 * 4;

constexpr int LDS_STRIDE = 72;
constexpr int TILE_ELEMS = 128 * LDS_STRIDE;
constexpr int LDS_BYTES = 4 * TILE_ELEMS * 2;
constexpr int NPHASE = 2 + 9 * DEPTH;

struct Params {
    const float *x, *c, *ctx, *c_ctx, *w_mod, *b_mod, *norm1_g, *w_in, *pool_w, *pool_scale, *na_rpb, *dec_f, *dec_b, *gn_g,
        *w_out, *norm2_g, *w_up, *conv_w, *conv_b, *w_down, *final_g;
    float* out;
    unsigned char* ws;
    int ph_lo, ph_hi;
};

__device__ __forceinline__ float bf2f(unsigned b) { return __uint_as_float(b << 16); }
__device__ __forceinline__ unsigned pack_bf16(float lo, float hi) {
    unsigned r;
    asm("v_cvt_pk_bf16_f32 %0, %1, %2" : "=v"(r) : "v"(lo), "v"(hi));
    return r;
}
__device__ __forceinline__ uint2 pack4(float a, float b, float c, float d) { return make_uint2(pack_bf16(a, b), pack_bf16(c, d)); }
__device__ __forceinline__ f32x4 mfma16(bf16x8 a, bf16x8 b, f32x4 c) { return __builtin_amdgcn_mfma_f32_16x16x32_bf16(a, b, c, 0, 0, 0); }
__device__ __forceinline__ bf16x8 mk8(uint2 lo, uint2 hi) {
    uint4 u = make_uint4(lo.x, lo.y, hi.x, hi.y);
    return *reinterpret_cast<bf16x8*>(&u);
}
__device__ __forceinline__ float silu_f(float v) { return v / (1.f + __expf(-v)); }

__device__ __forceinline__ int opaque_tid() {
    int t = threadIdx.x;
    asm volatile("" : "+v"(t));
    return t;
}

#define XB_TMO 128
#define XB_XCNT(j) (256 + 64 * (j))
#define XB_XSUB(j) (1280 + 64 * (j))
#define XB_XGEN(j) (2304 + 64 * (j))
#define XB_TOP 3328
#define XB_TOPGEN 3392
#define XCD_BAR_WORDS 3456
#define XB_SPIN_CAP (1u << 22)
#define LAS __attribute__((address_space(3)))
__device__ __forceinline__ unsigned xb_ld(unsigned* p) { return __hip_atomic_load(p, __ATOMIC_RELAXED, __HIP_MEMORY_SCOPE_AGENT); }
__device__ __forceinline__ unsigned xb_add(unsigned* p, unsigned v) { return __hip_atomic_fetch_add(p, v, __ATOMIC_RELAXED, __HIP_MEMORY_SCOPE_AGENT); }
__device__ __forceinline__ unsigned xb_xcc_id() { return (unsigned)__builtin_amdgcn_s_getreg((3 << 11) | 20) & 0xFu; }
#define XB_SPIN(cond, bar)                                                                 \
    do {                                                                                   \
        unsigned _sp = 0;                                                                  \
        while (cond) {                                                                     \
            __builtin_amdgcn_s_sleep(1);                                                   \
            if ((++_sp & 255u) == 0u) {                                                    \
                if (xb_ld(&(bar)[XB_TMO])) break;                                          \
                if (_sp > XB_SPIN_CAP) { atomicAdd(&(bar)[XB_TMO], 1u); break; }           \
            }                                                                              \
        }                                                                                  \
    } while (0)
struct XcdBarrier { unsigned* bar; unsigned x; volatile LAS unsigned* st; };
__device__ __forceinline__ XcdBarrier xcd_barrier_post(unsigned* bar, volatile LAS unsigned* st) {
    XcdBarrier b; b.bar = bar; b.x = xb_xcc_id(); b.st = st;
    if (threadIdx.x == 0) (void)xb_add(&bar[XB_XCNT(b.x)], 1u);
    return b;
}
__device__ __forceinline__ void xcd_barrier_complete(unsigned* bar, unsigned x, unsigned& nloc, unsigned& nx) {
    const unsigned G = gridDim.x * gridDim.y * gridDim.z;
    unsigned sum, cnt, mine, sp = 0u;
    for (;;) {
        sum = 0u; cnt = 0u; mine = 0u;
#pragma unroll
        for (unsigned j = 0; j < 16; ++j) { const unsigned c = xb_ld(&bar[XB_XCNT(j)]); sum += c; cnt += (c > 0u) ? 1u : 0u; mine = (j == x) ? c : mine; }
        if (sum == G) break;
        __builtin_amdgcn_s_sleep(1);
        if ((++sp & 255u) == 0u) { if (xb_ld(&bar[XB_TMO])) break; if (sp > XB_SPIN_CAP) { atomicAdd(&bar[XB_TMO], 1u); break; } }
    }
    nloc = mine > 0u ? mine : 1u; nx = cnt > 0u ? cnt : 1u;
}
__device__ __forceinline__ void xcd_barrier(const XcdBarrier& b) {
    asm volatile("s_waitcnt vmcnt(0)" ::: "memory");
    __syncthreads();
    if (threadIdx.x == 0) {
        unsigned* bar = b.bar;
        __builtin_amdgcn_s_waitcnt(0);
        unsigned nloc = b.st[0], nx = b.st[1];
        if (nloc == 0u) { xcd_barrier_complete(bar, b.x, nloc, nx); b.st[0] = nloc; b.st[1] = nx; }
        const unsigned old = xb_add(&bar[XB_XSUB(b.x)], 1u);
        const unsigned gen = old / nloc;
        if (old + 1u == (gen + 1u) * nloc) {
            __builtin_amdgcn_fence(__ATOMIC_RELEASE, "agent");
            asm volatile("s_waitcnt vmcnt(0)" ::: "memory");
            const unsigned og = xb_add(&bar[XB_TOP], 1u);
            const unsigned tg = og / nx;
            if (og + 1u == (tg + 1u) * nx) xb_add(&bar[XB_TOPGEN], 1u);
            else XB_SPIN(xb_ld(&bar[XB_TOPGEN]) == tg, bar);
            __builtin_amdgcn_fence(__ATOMIC_ACQUIRE, "agent");
            xb_add(&bar[XB_XGEN(b.x)], 1u);
            asm volatile("s_waitcnt vmcnt(0)" ::: "memory");
        } else {
            XB_SPIN(xb_ld(&bar[XB_XGEN(b.x)]) == gen, bar);
            __builtin_amdgcn_fence(__ATOMIC_ACQUIRE, "agent");
            asm volatile("s_waitcnt vmcnt(0)" ::: "memory");
        }
    }
    __syncthreads();
}

template <bool MASKA>
__device__ __forceinline__ void gemm_mainloop(const bf16_t* __restrict__ A, long a_row0, long a_lo, long a_hi, const bf16_t* __restrict__ Bt,
                                              int b_row0, int K, bool swapxy, bf16_t* lds, f32x4 (&acc)[4][4]) {
    const int tid = opaque_tid(), lane = tid & 63, wave = tid >> 6, wr = wave >> 1, wc = wave & 1, fr = lane & 15, fq = lane >> 4;
    const int lr = tid >> 3, ch = tid & 7;
#pragma unroll
    for (int i = 0; i < 4; ++i)
#pragma unroll
        for (int j = 0; j < 4; ++j) acc[i][j] = (f32x4){0.f, 0.f, 0.f, 0.f};
    uint4 ra[4], rb[4];
    const bf16_t* ap[4];
    bool aok[4];
#pragma unroll
    for (int i = 0; i < 4; ++i) {
        const long row = a_row0 + lr + 32 * i;
        aok[i] = !MASKA || (row >= a_lo && row < a_hi);
        ap[i] = A + (aok[i] ? row : a_lo) * (long)K + ch * 8;
    }
    const bf16_t* bp = Bt + (long)(b_row0 + lr) * K + ch * 8;
    const int nk = K >> 6;
    auto gload = [&](int kt) {
#pragma unroll
        for (int i = 0; i < 4; ++i) {
            ra[i] = *(const uint4*)(ap[i] + kt * 64);
            if (MASKA && !aok[i]) ra[i] = make_uint4(0u, 0u, 0u, 0u);
        }
#pragma unroll
        for (int i = 0; i < 4; ++i) rb[i] = *(const uint4*)(bp + (long)(32 * i) * K + kt * 64);
    };
    auto lstore = [&](int buf) {
        bf16_t* la = lds + buf * 2 * TILE_ELEMS;
        bf16_t* lb = la + TILE_ELEMS;
#pragma unroll
        for (int i = 0; i < 4; ++i) {
            *(uint4*)(la + (lr + 32 * i) * LDS_STRIDE + ch * 8) = ra[i];
            *(uint4*)(lb + (lr + 32 * i) * LDS_STRIDE + ch * 8) = rb[i];
        }
    };
    const int xoff = swapxy ? (wr * 64) * LDS_STRIDE : TILE_ELEMS + (wc * 64) * LDS_STRIDE;
    const int yoff = swapxy ? TILE_ELEMS + (wc * 64) * LDS_STRIDE : (wr * 64) * LDS_STRIDE;
    gload(0);
    lstore(0);
    __syncthreads();
    for (int kt = 0; kt < nk; ++kt) {
        if (kt + 1 < nk) gload(kt + 1);
        const bf16_t* base = lds + (kt & 1) * 2 * TILE_ELEMS;
        const bf16_t* lx = base + xoff + fr * LDS_STRIDE + fq * 8;
        const bf16_t* ly = base + yoff + fr * LDS_STRIDE + fq * 8;
#pragma unroll
        for (int ks = 0; ks < 2; ++ks) {
            bf16x8 xf[4], yf[4];
#pragma unroll
            for (int t = 0; t < 4; ++t) {
                xf[t] = *(const bf16x8*)(lx + t * 16 * LDS_STRIDE + ks * 32);
                yf[t] = *(const bf16x8*)(ly + t * 16 * LDS_STRIDE + ks * 32);
            }
#pragma unroll
            for (int xi = 0; xi < 4; ++xi)
#pragma unroll
                for (int yi = 0; yi < 4; ++yi) acc[xi][yi] = mfma16(xf[xi], yf[yi], acc[xi][yi]);
        }
        if (kt + 1 < nk) lstore((kt + 1) & 1);
        __syncthreads();
    }
}

__device__ void conv_weight_tile(const float* __restrict__ src, int N, bf16_t* __restrict__ dst, int K, int k0, int n0, int dst_row0, float* lds) {
    const int tid = opaque_tid();
#pragma unroll
    for (int i = 0; i < 4; ++i) {
        const int kk = (tid >> 4) + 16 * i, c4 = (tid & 15) * 4;
        const float4 v = *(const float4*)(src + (size_t)(k0 + kk) * N + n0 + c4);
        float* p = lds + kk * 65 + c4;
        p[0] = v.x; p[1] = v.y; p[2] = v.z; p[3] = v.w;
    }
    __syncthreads();
    const int nn = tid >> 2, ks = (tid & 3) * 16;
    unsigned w[8];
#pragma unroll
    for (int j = 0; j < 8; ++j) w[j] = pack_bf16(lds[(ks + 2 * j) * 65 + nn], lds[(ks + 2 * j + 1) * 65 + nn]);
    uint4* d = (uint4*)(dst + (size_t)(dst_row0 + nn) * K + k0 + ks);
    d[0] = make_uint4(w[0], w[1], w[2], w[3]);
    d[1] = make_uint4(w[4], w[5], w[6], w[7]);
    __syncthreads();
}

__device__ void phase_prep(const Params& p, float* lds) {
    const int tid = opaque_tid();
    bf16_t* wt = (bf16_t*)(p.ws + OFF_WT);
    constexpr int PER_LAYER = 736 + 256 + 1408 + 704;
    constexpr int NW = PER_LAYER * DEPTH;
    constexpr int NMOD = DEPTH * 96;
    for (int it = blockIdx.x; it < NW + NMOD; it += gridDim.x) {
        if (it < NW) {
            const int l = it / PER_LAYER;
            int r = it % PER_LAYER;
            bf16_t* wl = wt + (size_t)l * WT_LAYER;
            if (r < 736) {
                const int kt = r / 46, nt = r % 46;
                conv_weight_tile(p.w_in + (size_t)l * D * IN_DIM, IN_DIM, wl + WT_IN, D, kt * 64, nt * 64, nt * 64, lds);
            } else if (r < 736 + 256) {
                r -= 736;
                const int kt = r / 16, nt = r % 16;
                conv_weight_tile(p.w_out + (size_t)l * D * D, D, wl + WT_OUT, D, kt * 64, nt * 64, nt * 64, lds);
            } else if (r < 736 + 256 + 1408) {
                r -= 736 + 256;
                const int kt = r / 88, nt = r % 88;
                const int half = nt >= 44 ? 1 : 0, ti = nt - half * 44;
                conv_weight_tile(p.w_up + (size_t)l * D * NUP, NUP, wl + WT_UP, D, kt * 64, nt * 64, ti * 128 + half * 64, lds);
            } else {
                r -= 736 + 256 + 1408;
                const int kt = r / 16, nt = r % 16;
                conv_weight_tile(p.w_down + (size_t)l * DFF * D, D, wl + WT_DOWN, DFF, kt * 64, nt * 64, nt * 64, lds);
            }
        } else {
            const int mi = it - NW, l = mi / 96, col0 = (mi % 96) * 64;
            float* sx = lds;
            float* sc = lds + 1024;
            float* red = lds + 2048;
            for (int k = tid; k < 1024; k += 256) { sx[k] = silu_f(p.c[k]); sc[k] = silu_f(p.c_ctx[k]); }
            __syncthreads();
            const int kq = tid >> 4, cq = tid & 15;
            float ax[4] = {0.f, 0.f, 0.f, 0.f}, ac[4] = {0.f, 0.f, 0.f, 0.f};
            const float* wp = p.w_mod + ((size_t)l * 1024 + kq * 64) * 6144 + col0 + cq * 4;
#pragma unroll 8
            for (int k = 0; k < 64; ++k) {
                const float4 w4 = *(const float4*)(wp + (size_t)k * 6144);
                const float a = sx[kq * 64 + k], b = sc[kq * 64 + k];
                ax[0] += a * w4.x; ax[1] += a * w4.y; ax[2] += a * w4.z; ax[3] += a * w4.w;
                ac[0] += b * w4.x; ac[1] += b * w4.y; ac[2] += b * w4.z; ac[3] += b * w4.w;
            }
#pragma unroll
            for (int j = 0; j < 4; ++j) { red[(kq * 64 + cq * 4 + j) * 2] = ax[j]; red[(kq * 64 + cq * 4 + j) * 2 + 1] = ac[j]; }
            __syncthreads();
            if (tid < 128) {
                const int col = tid >> 1, which = tid & 1;
                float s = 0.f;
#pragma unroll
                for (int q = 0; q < 16; ++q) s += red[(q * 64 + col) * 2 + which];
                float* mod = (float*)(p.ws + OFF_MOD);
                mod[((size_t)l * 2 + which) * 6144 + col0 + col] = s + p.b_mod[(size_t)l * 6144 + col0 + col];
            }
            __syncthreads();
        }
    }
    float4* h4 = (float4*)(p.ws + OFF_H);
    const float4* x4 = (const float4*)p.x;
    const float4* c4 = (const float4*)p.ctx;
    const size_t nlat4 = (size_t)LAT * D / 4, ntot4 = (size_t)MT * D / 4;
    for (size_t i = (size_t)blockIdx.x * 256 + tid; i < ntot4; i += (size_t)gridDim.x * 256) h4[i] = i < nlat4 ? x4[i] : c4[i - nlat4];
    float* rope = (float*)(p.ws + OFF_ROPE);
    for (int i = blockIdx.x * 256 + tid; i < 4096; i += gridDim.x * 256) {
        const int pos = i >> 4, d = i & 15;
        const float inv = powf(10000.f, -(float)d / 16.f);
        const float ang = (float)pos * inv;
        rope[i] = cosf(ang);
        rope[4096 + i] = sinf(ang);
    }
}

__device__ void phase_norm(const Params& p, int l, const float* g, int shift_idx, int nrows) {
    const int tid = opaque_tid(), lane = tid & 63, wave = tid >> 6;
    const float* h = (const float*)(p.ws + OFF_H);
    bf16_t* out = (bf16_t*)(p.ws + OFF_AY);
    const float* mod = (const float*)(p.ws + OFF_MOD) + (size_t)l * 2 * 6144;
    for (int row = blockIdx.x * 4 + wave; row < nrows; row += gridDim.x * 4) {
        const float* hr = h + (size_t)row * D;
        const float* md = mod + (row >= LAT ? 6144 : 0) + shift_idx * D;
        float4 v[4];
        float ss = 0.f;
#pragma unroll
        for (int i = 0; i < 4; ++i) {
            v[i] = *(const float4*)(hr + i * 256 + lane * 4);
            ss += v[i].x * v[i].x + v[i].y * v[i].y + v[i].z * v[i].z + v[i].w * v[i].w;
        }
#pragma unroll
        for (int o = 32; o >= 1; o >>= 1) ss += __shfl_xor(ss, o);
        const float r = rsqrtf(ss * (1.f / D) + 1e-6f);
#pragma unroll
        for (int i = 0; i < 4; ++i) {
            const int col = i * 256 + lane * 4;
            const float4 gg = *(const float4*)(g + col), sh = *(const float4*)(md + col), sc = *(const float4*)(md + D + col);
            const float o0 = v[i].x * r * gg.x * (1.f + sc.x) + sh.x, o1 = v[i].y * r * gg.y * (1.f + sc.y) + sh.y;
            const float o2 = v[i].z * r * gg.z * (1.f + sc.z) + sh.z, o3 = v[i].w * r * gg.w * (1.f + sc.w) + sh.w;
            *(uint2*)(out + (size_t)row * D + col) = pack4(o0, o1, o2, o3);
        }
    }
}

__device__ void phase_final(const Params& p) {
    const int tid = opaque_tid(), lane = tid & 63, wave = tid >> 6;
    const float* h = (const float*)(p.ws + OFF_H);
    for (int row = blockIdx.x * 4 + wave; row < LAT; row += gridDim.x * 4) {
        const float* hr = h + (size_t)row * D;
        float4 v[4];
        float ss = 0.f;
#pragma unroll
        for (int i = 0; i < 4; ++i) {
            v[i] = *(const float4*)(hr + i * 256 + lane * 4);
            ss += v[i].x * v[i].x + v[i].y * v[i].y + v[i].z * v[i].z + v[i].w * v[i].w;
        }
#pragma unroll
        for (int o = 32; o >= 1; o >>= 1) ss += __shfl_xor(ss, o);
        const float r = rsqrtf(ss * (1.f / D) + 1e-6f);
#pragma unroll
        for (int i = 0; i < 4; ++i) {
            const int col = i * 256 + lane * 4;
            const float4 gg = *(const float4*)(p.final_g + col);
            *(float4*)(p.out + (size_t)row * D + col) = make_float4(v[i].x * r * gg.x, v[i].y * r * gg.y, v[i].z * r * gg.z, v[i].w * r * gg.w);
        }
    }
}

__device__ void phase_inproj(const Params& p, int l, bf16_t* lds) {
    const int tid = opaque_tid(), lane = tid & 63, wave = tid >> 6, wr = wave >> 1, wc = wave & 1, fr = lane & 15, fq = lane >> 4;
    const bf16_t* A = (const bf16_t*)(p.ws + OFF_AY);
    const bf16_t* Bt = (const bf16_t*)(p.ws + OFF_WT) + (size_t)l * WT_LAYER + WT_IN;
    bf16_t* P = (bf16_t*)(p.ws + OFF_P);
    const float* rope = (const float*)(p.ws + OFF_ROPE);
    constexpr int NTN = IN_DIM / 128;
    for (int tile = blockIdx.x; tile < NCHUNK * NTN; tile += gridDim.x) {
        const int mt = tile / NTN, nt = tile % NTN;
        const int col0 = nt * 128 + wc * 64;
        const bool tr = (col0 >= C_NV && col0 < C_RQ) || (col0 >= C_RV && col0 < C_GT);
        f32x4 acc[4][4];
        gemm_mainloop<false>(A, (long)mt * 128, 0, MT, Bt, nt * 128, D, tr, lds, acc);
        const int row0 = mt * 128 + wr * 64;
        if (tr) {
            bf16_t* vt = (bf16_t*)(p.ws + (col0 >= C_RV ? OFF_RVT : OFF_NVT));
            const int cb = col0 - (col0 >= C_RV ? C_RV : C_NV);
#pragma unroll
            for (int xi = 0; xi < 4; ++xi)
#pragma unroll
                for (int yi = 0; yi < 4; ++yi) {
                    const f32x4 v = acc[xi][yi];
                    *(uint2*)(vt + (size_t)(cb + yi * 16 + fr) * MT + row0 + xi * 16 + fq * 4) = pack4(v[0], v[1], v[2], v[3]);
                }
        } else {
            const bool is_rq = col0 >= C_RQ && col0 < C_RK, is_rk = col0 >= C_RK && col0 < C_RV;
            const bool is_gate = col0 >= C_GT, is_nq = col0 >= C_NQ && col0 < C_NK;
            if (is_rq || is_rk) {
                const int hh = (col0 - (is_rq ? C_RQ : C_RK)) >> 6;
                const float lgf = p.dec_f[l * 6 + hh], lgb = p.dec_b[l * 6 + hh];
                bf16_t* kf = (bf16_t*)(p.ws + OFF_RKF);
                bf16_t* kb = (bf16_t*)(p.ws + OFF_RKB);
                const float sc = is_rk ? 0.125f : 1.f;
#pragma unroll
                for (int yi = 0; yi < 4; ++yi) {
                    const int row = row0 + yi * 16 + fr;
                    f32x4 v0 = acc[0][yi], v1 = acc[1][yi], v2 = acc[2][yi], v3 = acc[3][yi];
                    if (row < LAT) {
                        const int pr = row >> 6, pc = row & 63;
                        const f32x4 cr = *(const f32x4*)(rope + pr * 16 + fq * 4), sr = *(const f32x4*)(rope + 4096 + pr * 16 + fq * 4);
                        const f32x4 cc = *(const f32x4*)(rope + pc * 16 + fq * 4), sn = *(const f32x4*)(rope + 4096 + pc * 16 + fq * 4);
                        const f32x4 o0 = v0 * cr - v1 * sr, o1 = v0 * sr + v1 * cr, o2 = v2 * cc - v3 * sn, o3 = v2 * sn + v3 * cc;
                        v0 = o0; v1 = o1; v2 = o2; v3 = o3;
                    }
                    v0 *= sc; v1 *= sc; v2 *= sc; v3 *= sc;
                    bf16_t* pr_ = P + (size_t)row * IN_DIM + col0 + fq * 4;
                    *(uint2*)(pr_) = pack4(v0[0], v0[1], v0[2], v0[3]);
                    *(uint2*)(pr_ + 16) = pack4(v1[0], v1[1], v1[2], v1[3]);
                    *(uint2*)(pr_ + 32) = pack4(v2[0], v2[1], v2[2], v2[3]);
                    *(uint2*)(pr_ + 48) = pack4(v3[0], v3[1], v3[2], v3[3]);
                    if (is_rk) {
                        const int c = row & 127;
                        const float df = __expf((float)(127 - c) * lgf), db = __expf((float)c * lgb);
                        const int rb = (col0 - C_RK) + fq * 4;
                        const f32x4 vv[4] = {v0, v1, v2, v3};
#pragma unroll
                        for (int xi = 0; xi < 4; ++xi)
#pragma unroll
                            for (int j = 0; j < 4; ++j) {
                                const size_t o = (size_t)(rb + xi * 16 + j) * MT + row;
                                kf[o] = (bf16_t)(pack_bf16(vv[xi][j] * df, 0.f) & 0xffffu);
                                kb[o] = (bf16_t)(pack_bf16(vv[xi][j] * db, 0.f) & 0xffffu);
                            }
                    }
                }
            } else {
#pragma unroll
                for (int yi = 0; yi < 4; ++yi) {
                    const int row = row0 + yi * 16 + fr;
#pragma unroll
                    for (int xi = 0; xi < 4; ++xi) {
                        f32x4 v = acc[xi][yi];
                        if (is_nq) v *= 0.125f;
                        if (is_gate) { v[0] = silu_f(v[0]); v[1] = silu_f(v[1]); v[2] = silu_f(v[2]); v[3] = silu_f(v[3]); }
                        *(uint2*)(P + (size_t)row * IN_DIM + col0 + xi * 16 + fq * 4) = pack4(v[0], v[1], v[2], v[3]);
                    }
                }
            }
        }
    }
}

__device__ void phase_resid(const Params& p, int l, const bf16_t* A, const bf16_t* Bt, int K, int gate_idx, int mtiles, bf16_t* lds) {
    const int tid = opaque_tid(), lane = tid & 63, wave = tid >> 6, wr = wave >> 1, wc = wave & 1, fr = lane & 15, fq = lane >> 4;
    float* h = (float*)(p.ws + OFF_H);
    const float* mod = (const float*)(p.ws + OFF_MOD) + (size_t)l * 2 * 6144 + gate_idx * D;
    for (int tile = blockIdx.x; tile < mtiles * 8; tile += gridDim.x) {
        const int mt = tile >> 3, nt = tile & 7;
        f32x4 acc[4][4];
        gemm_mainloop<false>(A, (long)mt * 128, 0, MT, Bt, nt * 128, K, false, lds, acc);
        const float* gv = mod + (mt >= 128 ? 6144 : 0);
        const int row0 = mt * 128 + wr * 64, col0 = nt * 128 + wc * 64;
#pragma unroll
        for (int xi = 0; xi < 4; ++xi) {
            const int col = col0 + xi * 16 + fq * 4;
            const f32x4 g = *(const f32x4*)(gv + col);
#pragma unroll
            for (int yi = 0; yi < 4; ++yi) {
                float* hp = h + (size_t)(row0 + yi * 16 + fr) * D + col;
                f32x4 hv = *(const f32x4*)hp;
                hv += g * acc[xi][yi];
                *(f32x4*)hp = hv;
            }
        }
    }
}

__device__ void phase_up(const Params& p, int l, bool with_ctx, bf16_t* lds) {
    const int tid = opaque_tid(), lane = tid & 63, wave = tid >> 6, wr = wave >> 1, wc = wave & 1, fr = lane & 15, fq = lane >> 4;
    const bf16_t* A = (const bf16_t*)(p.ws + OFF_AY);
    const bf16_t* Bt = (const bf16_t*)(p.ws + OFF_WT) + (size_t)l * WT_LAYER + WT_UP;
    bf16_t* G = (bf16_t*)(p.ws + OFF_P);
    float* stg = (float*)lds;
    const int mtiles = 131 + (with_ctx ? 3 : 0);
    const float* cw = p.conv_w + (size_t)l * 3 * NUP;
    const float* cb = p.conv_b + (size_t)l * NUP;
    for (int tile = blockIdx.x; tile < mtiles * 44; tile += gridDim.x) {
        const int mt = tile / 44, nt = tile % 44;
        const long s0 = mt < 131 ? 0 : LAT, s1 = mt < 131 ? LAT : MT;
        const long arow0 = s0 + 126 * (mt < 131 ? mt : mt - 131) - 1;
        f32x4 acc[4][4];
        gemm_mainloop<true>(A, arow0, s0, s1, Bt, nt * 128, D, false, lds, acc);
#pragma unroll
        for (int xi = 0; xi < 4; ++xi)
#pragma unroll
            for (int yi = 0; yi < 4; ++yi) *(f32x4*)(stg + (wr * 64 + yi * 16 + fr) * 132 + wc * 64 + xi * 16 + fq * 4) = acc[xi][yi];
        __syncthreads();
        {
            const int c = tid & 63, ff = nt * 64 + c;
            const float wa0 = cw[ff], wa1 = cw[NUP + ff], wa2 = cw[2 * NUP + ff], ba = cb[ff];
            const float wb0 = cw[DFF + ff], wb1 = cw[NUP + DFF + ff], wb2 = cw[2 * NUP + DFF + ff], bb = cb[DFF + ff];
            for (int t = 1 + (tid >> 6); t <= 126; t += 4) {
                const long grow = arow0 + t;
                if (grow < s1) {
                    const float ua = wa0 * stg[(t - 1) * 132 + c] + wa1 * stg[t * 132 + c] + wa2 * stg[(t + 1) * 132 + c] + ba;
                    const float ub = wb0 * stg[(t - 1) * 132 + 64 + c] + wb1 * stg[t * 132 + 64 + c] + wb2 * stg[(t + 1) * 132 + 64 + c] + bb;
                    G[(size_t)grow * DFF + ff] = (bf16_t)(pack_bf16(silu_f(ua) * ub, 0.f) & 0xffffu);
                }
            }
        }
        __syncthreads();
    }
}

__device__ void pool_item(const Params& p, int l, int item, float* lds) {
    const int tid = opaque_tid();
    const int g = item & 3, tt = item >> 2;
    const int t0 = tt * 64;
    const int s0 = t0 < LAT ? 0 : LAT, s1 = t0 < LAT ? LAT : MT;
    const bf16_t* P = (const bf16_t*)(p.ws + OFF_P);
    bf16_t* Y = (bf16_t*)(p.ws + OFF_AY);
    float* pin = lds;
    float* dif = lds + 80 * 64;
    float* w = dif + 64 * 65;
    for (int i = tid; i < 80 * 8; i += 256) {
        const int rr = i >> 3, c8 = (i & 7) * 8;
        int tok = t0 - 8 + rr;
        tok = tok < s0 ? s0 : (tok >= s1 ? s1 - 1 : tok);
        const uint4 u = *(const uint4*)(P + (size_t)tok * IN_DIM + C_POOL + g * 64 + c8);
        float* d = pin + rr * 64 + c8;
        d[0] = bf2f(u.x & 0xffffu); d[1] = bf2f(u.x >> 16); d[2] = bf2f(u.y & 0xffffu); d[3] = bf2f(u.y >> 16);
        d[4] = bf2f(u.z & 0xffffu); d[5] = bf2f(u.z >> 16); d[6] = bf2f(u.w & 0xffffu); d[7] = bf2f(u.w >> 16);
    }
    const float* wg = p.pool_w + ((size_t)l * 4 + g) * 4096;
    for (int i = tid; i < 1024; i += 256) *(float4*)(w + i * 4) = *(const float4*)(wg + i * 4);
    __syncthreads();
    {
        const int tk = tid >> 2, cq = (tid & 3) * 16;
        const int t = t0 + tk, win = 2 << g;
        int lo = t - win / 2, hi = lo + win;
        lo = lo < s0 ? s0 : lo;
        hi = hi > s1 ? s1 : hi;
        const float invn = 1.f / (float)(hi - lo);
#pragma unroll
        for (int c = 0; c < 16; ++c) {
            float s = 0.f;
            for (int u = lo; u < hi; ++u) s += pin[(u - t0 + 8) * 64 + cq + c];
            dif[tk * 65 + cq + c] = s * invn - pin[(tk + 8) * 64 + cq + c];
        }
    }
    __syncthreads();
    {
        const int tk = tid >> 2, dq = (tid & 3) * 16;
        float acc[16];
#pragma unroll
        for (int j = 0; j < 16; ++j) acc[j] = 0.f;
        for (int c = 0; c < 64; ++c) {
            const float dv = dif[tk * 65 + c];
            const float* wr_ = w + c * 64 + dq;
#pragma unroll
            for (int j = 0; j < 16; ++j) acc[j] += dv * wr_[j];
        }
        const float* sc = p.pool_scale + (size_t)l * 256 + g * 64 + dq;
        uint4 o0, o1;
        o0.x = pack_bf16(acc[0] * sc[0], acc[1] * sc[1]); o0.y = pack_bf16(acc[2] * sc[2], acc[3] * sc[3]);
        o0.z = pack_bf16(acc[4] * sc[4], acc[5] * sc[5]); o0.w = pack_bf16(acc[6] * sc[6], acc[7] * sc[7]);
        o1.x = pack_bf16(acc[8] * sc[8], acc[9] * sc[9]); o1.y = pack_bf16(acc[10] * sc[10], acc[11] * sc[11]);
        o1.z = pack_bf16(acc[12] * sc[12], acc[13] * sc[13]); o1.w = pack_bf16(acc[14] * sc[14], acc[15] * sc[15]);
        uint4* dst = (uint4*)(Y + (size_t)(t0 + tk) * D + g * 64 + dq);
        dst[0] = o0;
        dst[1] = o1;
    }
    __syncthreads();
}

__device__ void na_item(const Params& p, int item, const float* rpb  ) {
    const int lane = opaque_tid() & 63, fr = lane & 15, fq = lane >> 4;
    const bf16_t* P = (const bf16_t*)(p.ws + OFF_P);
    const bf16_t* NVt = (const bf16_t*)(p.ws + OFF_NVT);
    bf16_t* Y = (bf16_t*)(p.ws + OFF_AY);
    int h, q0, r = 0, n = 0, rs = 0, cs = 0, nloc;
    if (item < 6144) {
        h = item % 6;
        const int rn = item / 6;
        n = rn & 3; r = rn >> 2;
        q0 = r * 64 + n * 16;
        rs = r - 4; rs = rs < 0 ? 0 : (rs > 248 ? 248 : rs);
        cs = n * 16 - 8; cs = cs < 0 ? 0 : (cs > 32 ? 32 : cs);
        nloc = 8;
    } else {
        const int ci = item - 6144;
        h = ci % 6;
        q0 = LAT + (ci / 6) * 16;
        nloc = 0;
    }
    bf16x8 qf[2];
#pragma unroll
    for (int ks = 0; ks < 2; ++ks) qf[ks] = *(const bf16x8*)(P + (size_t)(q0 + fr) * IN_DIM + C_NQ + h * 64 + ks * 32 + fq * 8);
    f32x4 o[4];
#pragma unroll
    for (int dt = 0; dt < 4; ++dt) o[dt] = (f32x4){0.f, 0.f, 0.f, 0.f};
    float m = -1e30f, lsum = 0.f;
    const int qc = n * 16 + fr;
    int wsn = qc - 8; wsn = wsn < 0 ? 0 : (wsn > 48 ? 48 : wsn);
    const int nsteps = nloc + 8;
#pragma unroll 1
    for (int s = 0; s < nsteps; ++s) {
        const bool loc = s < nloc;
        const int tb = loc ? (rs + s) * 64 + cs : LAT + (s - nloc) * 32;
        f32x4 st[2];
#pragma unroll
        for (int kt = 0; kt < 2; ++kt) {
            const bf16_t* kp = P + (size_t)(tb + kt * 16 + fr) * IN_DIM + C_NK + h * 64 + fq * 8;
            const bf16x8 k0 = *(const bf16x8*)kp, k1 = *(const bf16x8*)(kp + 32);
            st[kt] = mfma16(k0, qf[0], (f32x4){0.f, 0.f, 0.f, 0.f});
            st[kt] = mfma16(k1, qf[1], st[kt]);
        }
        if (loc) {
            const float* rb = rpb + (h * 15 + (rs + s - r + 7)) * 31;
#pragma unroll
            for (int kt = 0; kt < 2; ++kt)
#pragma unroll
                for (int j = 0; j < 4; ++j) {
                    const int kcol = cs + kt * 16 + fq * 4 + j;
                    const bool valid = kcol >= wsn && kcol < wsn + 16;
                    int dc = kcol - qc + 15; dc = dc < 0 ? 0 : (dc > 30 ? 30 : dc);
                    st[kt][j] = valid ? st[kt][j] + rb[dc] : -1e30f;
                }
        }
        float mx = fmaxf(fmaxf(fmaxf(st[0][0], st[0][1]), fmaxf(st[0][2], st[0][3])), fmaxf(fmaxf(st[1][0], st[1][1]), fmaxf(st[1][2], st[1][3])));
        mx = fmaxf(mx, __shfl_xor(mx, 16));
        mx = fmaxf(mx, __shfl_xor(mx, 32));
        const float mn = fmaxf(m, mx);
        const float alpha = __expf(m - mn);
        m = mn;
        float pv[8], ps = 0.f;
#pragma unroll
        for (int kt = 0; kt < 2; ++kt)
#pragma unroll
            for (int j = 0; j < 4; ++j) { pv[kt * 4 + j] = __expf(st[kt][j] - mn); ps += pv[kt * 4 + j]; }
        lsum = lsum * alpha + ps;
        const uint4 pu = make_uint4(pack_bf16(pv[0], pv[1]), pack_bf16(pv[2], pv[3]), pack_bf16(pv[4], pv[5]), pack_bf16(pv[6], pv[7]));
        const bf16x8 pf = *reinterpret_cast<const bf16x8*>(&pu);
#pragma unroll
        for (int dt = 0; dt < 4; ++dt) {
            const bf16_t* vp = NVt + (size_t)(h * 64 + dt * 16 + fr) * MT + tb + fq * 4;
            const bf16x8 vf = mk8(*(const uint2*)vp, *(const uint2*)(vp + 16));
            o[dt] *= alpha;
            o[dt] = mfma16(vf, pf, o[dt]);
        }
    }
    lsum += __shfl_xor(lsum, 16);
    lsum += __shfl_xor(lsum, 32);
    const float il = 1.f / lsum;
#pragma unroll
    for (int dt = 0; dt < 4; ++dt)
        *(uint2*)(Y + (size_t)(q0 + fr) * D + 256 + h * 64 + dt * 16 + fq * 4) = pack4(o[dt][0] * il, o[dt][1] * il, o[dt][2] * il, o[dt][3] * il);
}

__device__ void retu_item(const Params& p, int item) {
    const int lane = opaque_tid() & 63, fr = lane & 15, fq = lane >> 4;
    const int dir = item & 1, ch_h = item >> 1, h = ch_h % 6, chunk = ch_h / 6;
    const bf16_t* Vt = (const bf16_t*)(p.ws + OFF_RVT) + (size_t)(h * 64) * MT + chunk * 128;
    const bf16_t* Kt = (const bf16_t*)(p.ws + (dir ? OFF_RKB : OFF_RKF)) + (size_t)(h * 64) * MT + chunk * 128;
    float* U = (float*)(p.ws + OFF_US) + ((size_t)(chunk * 2 + dir) * 6 + h) * 4096;
    f32x4 acc[4][4];
#pragma unroll
    for (int i = 0; i < 4; ++i)
#pragma unroll
        for (int j = 0; j < 4; ++j) acc[i][j] = (f32x4){0.f, 0.f, 0.f, 0.f};
#pragma unroll 1
    for (int ks = 0; ks < 4; ++ks) {
        bf16x8 vf[4], kf[4];
#pragma unroll
        for (int t = 0; t < 4; ++t) {
            vf[t] = *(const bf16x8*)(Vt + (size_t)(t * 16 + fr) * MT + ks * 32 + fq * 8);
            kf[t] = *(const bf16x8*)(Kt + (size_t)(t * 16 + fr) * MT + ks * 32 + fq * 8);
        }
#pragma unroll
        for (int et = 0; et < 4; ++et)
#pragma unroll
            for (int dt = 0; dt < 4; ++dt) acc[et][dt] = mfma16(vf[et], kf[dt], acc[et][dt]);
    }
#pragma unroll
    for (int et = 0; et < 4; ++et)
#pragma unroll
        for (int dt = 0; dt < 4; ++dt)
#pragma unroll
            for (int j = 0; j < 4; ++j) U[(et * 16 + fq * 4 + j) * 64 + dt * 16 + fr] = acc[et][dt][j];
}

__device__ void phase_scan(const Params& p, int l) {
    float* US = (float*)(p.ws + OFF_US);
    for (int e = blockIdx.x * 256 + opaque_tid(); e < 2 * 6 * 4096; e += gridDim.x * 256) {
        const int dir = e / 24576, rem = e % 24576, h = rem >> 12, ed = rem & 4095;
        const float lg = dir ? p.dec_b[l * 6 + h] : p.dec_f[l * 6 + h];
        const float cd = __expf(128.f * lg);
        float s = 0.f;
        for (int b = 0; b < 10; ++b) {
            float u[13];
            size_t idx[13];
#pragma unroll
            for (int i = 0; i < 13; ++i) {
                const int q = b * 13 + i;
                int chunk;
                if (dir == 0) chunk = q < 2 ? 128 + q : q - 2;
                else chunk = q < 2 ? 129 - q : 129 - q;
                idx[i] = ((size_t)(chunk * 2 + dir) * 6 + h) * 4096 + ed;
                u[i] = US[idx[i]];
            }
#pragma unroll
            for (int i = 0; i < 13; ++i) {
                US[idx[i]] = s;
                s = s * cd + u[i];
            }
        }
    }
}

__device__ void reto_item(const Params& p, int l, int item) {
    const int lane = opaque_tid() & 63, fr = lane & 15, fq = lane >> 4;
    const int iq = item & 3, ch_h = item >> 2, h = ch_h % 6, chunk = ch_h / 6;
    const int tok0 = chunk * 128;
    const bf16_t* P = (const bf16_t*)(p.ws + OFF_P);
    const bf16_t* RVt = (const bf16_t*)(p.ws + OFF_RVT);
    const float* US = (const float*)(p.ws + OFF_US);
    bf16_t* Y = (bf16_t*)(p.ws + OFF_AY);
    const float lgf = p.dec_f[l * 6 + h], lgb = p.dec_b[l * 6 + h];
    bf16x8 qf[2][2];
#pragma unroll
    for (int it = 0; it < 2; ++it)
#pragma unroll
        for (int ks = 0; ks < 2; ++ks) qf[it][ks] = *(const bf16x8*)(P + (size_t)(tok0 + iq * 32 + it * 16 + fr) * IN_DIM + C_RQ + h * 64 + ks * 32 + fq * 8);
    f32x4 y[4][2];
#pragma unroll
    for (int et = 0; et < 4; ++et)
#pragma unroll
        for (int it = 0; it < 2; ++it) y[et][it] = (f32x4){0.f, 0.f, 0.f, 0.f};
#pragma unroll 1
    for (int pp = 0; pp < 4; ++pp) {
        f32x4 a[2][2];
#pragma unroll
        for (int jj = 0; jj < 2; ++jj) {
            const bf16_t* kp = P + (size_t)(tok0 + (2 * pp + jj) * 16 + fr) * IN_DIM + C_RK + h * 64 + fq * 8;
            const bf16x8 k0 = *(const bf16x8*)kp, k1 = *(const bf16x8*)(kp + 32);
#pragma unroll
            for (int it = 0; it < 2; ++it) {
                a[jj][it] = mfma16(k0, qf[it][0], (f32x4){0.f, 0.f, 0.f, 0.f});
                a[jj][it] = mfma16(k1, qf[it][1], a[jj][it]);
            }
        }
        bf16x8 bt[2];
#pragma unroll
        for (int it = 0; it < 2; ++it) {
            const int i = iq * 32 + it * 16 + fr;
            float pv[8];
#pragma unroll
            for (int jj = 0; jj < 2; ++jj)
#pragma unroll
                for (int rr = 0; rr < 4; ++rr) {
                    const int j = (2 * pp + jj) * 16 + fq * 4 + rr;
                    const int df = i - j;
                    const float dcy = (df >= 0 ? __expf((float)df * lgf) : 0.f) + (df <= 0 ? __expf((float)(-df) * lgb) : 0.f);
                    pv[jj * 4 + rr] = a[jj][it][rr] * dcy;
                }
            const uint4 pu = make_uint4(pack_bf16(pv[0], pv[1]), pack_bf16(pv[2], pv[3]), pack_bf16(pv[4], pv[5]), pack_bf16(pv[6], pv[7]));
            bt[it] = *reinterpret_cast<const bf16x8*>(&pu);
        }
#pragma unroll
        for (int et = 0; et < 4; ++et) {
            const bf16_t* vp = RVt + (size_t)(h * 64 + et * 16 + fr) * MT + tok0 + pp * 32 + fq * 4;
            const bf16x8 vf = mk8(*(const uint2*)vp, *(const uint2*)(vp + 16));
#pragma unroll
            for (int it = 0; it < 2; ++it) y[et][it] = mfma16(vf, bt[it], y[et][it]);
        }
    }
#pragma unroll
    for (int dir = 0; dir < 2; ++dir) {
        const float* St = US + ((size_t)(chunk * 2 + dir) * 6 + h) * 4096;
        f32x4 z[4][2];
#pragma unroll
        for (int et = 0; et < 4; ++et) {
            z[et][0] = (f32x4){0.f, 0.f, 0.f, 0.f};
            z[et][1] = (f32x4){0.f, 0.f, 0.f, 0.f};
#pragma unroll
            for (int ks = 0; ks < 2; ++ks) {
                const float* sp = St + (et * 16 + fr) * 64 + ks * 32 + fq * 8;
                const float4 s0 = *(const float4*)sp, s1 = *(const float4*)(sp + 4);
                const uint4 su = make_uint4(pack_bf16(s0.x, s0.y), pack_bf16(s0.z, s0.w), pack_bf16(s1.x, s1.y), pack_bf16(s1.z, s1.w));
                const bf16x8 sf = *reinterpret_cast<const bf16x8*>(&su);
                z[et][0] = mfma16(sf, qf[0][ks], z[et][0]);
                z[et][1] = mfma16(sf, qf[1][ks], z[et][1]);
            }
        }
#pragma unroll
        for (int it = 0; it < 2; ++it) {
            const int ii = iq * 32 + it * 16 + fr;
            const float sc = dir == 0 ? __expf((float)(ii + 1) * lgf) : __expf((float)(128 - ii) * lgb);
#pragma unroll
            for (int et = 0; et < 4; ++et) y[et][it] += z[et][it] * sc;
        }
    }
#pragma unroll
    for (int it = 0; it < 2; ++it) {
        float s = 0.f;
#pragma unroll
        for (int et = 0; et < 4; ++et) s += y[et][it][0] + y[et][it][1] + y[et][it][2] + y[et][it][3];
        s += __shfl_xor(s, 16);
        s += __shfl_xor(s, 32);
        const float mu = s * (1.f / 64.f);
        float v = 0.f;
#pragma unroll
        for (int et = 0; et < 4; ++et)
#pragma unroll
            for (int j = 0; j < 4; ++j) { const float d = y[et][it][j] - mu; v += d * d; }
        v += __shfl_xor(v, 16);
        v += __shfl_xor(v, 32);
        const float rs = rsqrtf(v * (1.f / 64.f) + 1e-6f);
        const int tok = tok0 + iq * 32 + it * 16 + fr;
#pragma unroll
        for (int et = 0; et < 4; ++et) {
            const int e0 = et * 16 + fq * 4;
            const f32x4 gn = *(const f32x4*)(p.gn_g + (size_t)l * 384 + h * 64 + e0);
            const uint2 gu = *(const uint2*)(P + (size_t)tok * IN_DIM + C_GT + h * 64 + e0);
            const float g0 = bf2f(gu.x & 0xffffu), g1 = bf2f(gu.x >> 16), g2 = bf2f(gu.y & 0xffffu), g3 = bf2f(gu.y >> 16);
            *(uint2*)(Y + (size_t)tok * D + 640 + h * 64 + e0) =
                pack4((y[et][it][0] - mu) * rs * gn[0] * g0, (y[et][it][1] - mu) * rs * gn[1] * g1, (y[et][it][2] - mu) * rs * gn[2] * g2,
                      (y[et][it][3] - mu) * rs * gn[3] * g3);
        }
    }
}

__device__ void phase_mix1(const Params& p, int l, float* lds) {
    const int tid = opaque_tid(), wave = tid >> 6;
    const bool with_ctx = l < DEPTH - 1;
    const int npool = (with_ctx ? MT : LAT) / 64 * 4;
    for (int it = blockIdx.x; it < npool; it += gridDim.x) pool_item(p, l, it, lds);
    for (int i = tid; i < 6 * 15 * 31; i += 256) lds[i] = p.na_rpb[(size_t)l * 6 * 15 * 31 + i];
    __syncthreads();
    const int gw = blockIdx.x * 4 + wave, nw = gridDim.x * 4;
    const int nna = 6144 + (with_ctx ? 96 : 0);
    for (int it = gw; it < nna; it += nw) na_item(p, it, lds);
    for (int it = gw; it < NCHUNK * 6 * 2; it += nw) retu_item(p, it);
    __syncthreads();
}
__device__ void phase_mix3(const Params& p, int l) {
    const int wave = opaque_tid() >> 6;
    const bool with_ctx = l < DEPTH - 1;
    const int n = (with_ctx ? NCHUNK : 128) * 6 * 4;
    for (int it = blockIdx.x * 4 + wave; it < n; it += gridDim.x * 4) reto_item(p, l, it);
}

__device__ void run_phase(const Params& p, int ph, unsigned char* lds) {
    if (ph == 0) { phase_prep(p, (float*)lds); return; }
    if (ph == NPHASE - 1) { phase_final(p); return; }
    const int l = (ph - 1) / 9, s = (ph - 1) % 9;
    const bool with_ctx = l < DEPTH - 1;
    const bf16_t* wl = (const bf16_t*)(p.ws + OFF_WT) + (size_t)l * WT_LAYER;
    switch (s) {
        case 0: phase_norm(p, l, p.norm1_g + (size_t)l * D, 0, MT); break;
        case 1: phase_inproj(p, l, (bf16_t*)lds); break;
        case 2: phase_mix1(p, l, (float*)lds); break;
        case 3: phase_scan(p, l); break;
        case 4: phase_mix3(p, l); break;
        case 5: phase_resid(p, l, (const bf16_t*)(p.ws + OFF_AY), wl + WT_OUT, D, 2, with_ctx ? NCHUNK : 128, (bf16_t*)lds); break;
        case 6: phase_norm(p, l, p.norm2_g + (size_t)l * D, 3, with_ctx ? MT : LAT); break;
        case 7: phase_up(p, l, with_ctx, (bf16_t*)lds); break;
        case 8: phase_resid(p, l, (const bf16_t*)(p.ws + OFF_P), wl + WT_DOWN, DFF, 5, with_ctx ? NCHUNK : 128, (bf16_t*)lds); break;
    }
}

__global__ void __launch_bounds__(256, 2) fwd_kernel(Params p) {
    extern __shared__ __attribute__((aligned(16))) unsigned char lds[];
    __shared__ uint4 xb_words;
#if ONE_LAUNCH
    cg::grid_group grid = cg::this_grid();
    if (threadIdx.x == 0) xb_words = make_uint4(0u, 0u, 0u, 0u);
    __syncthreads();
    XcdBarrier xb = xcd_barrier_post((unsigned*)(p.ws + OFF_BAR), (volatile LAS unsigned*)&xb_words);
#endif
    for (int ph = p.ph_lo; ph < p.ph_hi; ++ph) {
        run_phase(p, ph, lds);
#if ONE_LAUNCH
        if (ph + 1 < p.ph_hi) {
            if (ph == p.ph_lo) grid.sync();
            else xcd_barrier(xb);
        }
#endif
    }
}

extern "C" void kernel_launch(void* const* d_in, const int* in_sizes, int n_in, void* d_out, int out_size, void* d_ws, size_t ws_size,
                              hipStream_t stream) {
    static int grid_blocks = 0;
    if (!grid_blocks) {
        int dev = 0, cus = 0, per_cu = 0;
        hipGetDevice(&dev);
        hipDeviceGetAttribute(&cus, hipDeviceAttributeMultiprocessorCount, dev);
        hipFuncSetAttribute((const void*)fwd_kernel, hipFuncAttributeMaxDynamicSharedMemorySize, LDS_BYTES);
        hipOccupancyMaxActiveBlocksPerMultiprocessor(&per_cu, (const void*)fwd_kernel, 256, LDS_BYTES);
        if (per_cu < 1) per_cu = 1;
        if (per_cu > 2) per_cu = 2;
        grid_blocks = cus * per_cu;
        if (ws_size < WS_END) fprintf(stderr, "kernel_launch: workspace too small: %zu < %zu\n", ws_size, (size_t)WS_END);
    }
    Params p{};
    const float** pf = (const float**)&p;
    for (int i = 0; i < 21; ++i) pf[i] = (const float*)d_in[i];
    p.out = (float*)d_out;
    p.ws = (unsigned char*)d_ws;
#if ONE_LAUNCH
    hipMemsetAsync((unsigned char*)d_ws + OFF_BAR, 0, 16384, stream);
    p.ph_lo = 0;
    p.ph_hi = NPHASE;
    void* args[] = {&p};
    hipError_t e = hipLaunchCooperativeKernel((const void*)fwd_kernel, dim3(grid_blocks), dim3(256), args, LDS_BYTES, stream);
    if (e != hipSuccess) fprintf(stderr, "cooperative launch failed: %s (grid %d)\n", hipGetErrorString(e), grid_blocks);
#else
    for (int ph = 0; ph < NPHASE; ++ph) {
        p.ph_lo = ph;
        p.ph_hi = ph + 1;
        hipLaunchKernelGGL(fwd_kernel, dim3(grid_blocks), dim3(256), LDS_BYTES, stream, p);
    }
#endif
}
```

```cpp
#include <hip/hip_runtime.h>
#include <hip/hip_cooperative_groups.h>
#include <cstdio>
#include <cstdint>
namespace cg = cooperative_groups;

#ifndef ONE_LAUNCH
#define ONE_LAUNCH 1
#endif
#ifndef PROBE_DUP
#define PROBE_DUP -1
#endif

typedef unsigned short bf16_t;
typedef short bf16x8 __attribute__((ext_vector_type(8)));
typedef float f32x4 __attribute__((ext_vector_type(4)));

constexpr int D = 1024, LAT = 16384, NCTX = 256, MT = LAT + NCTX, DEPTH = 4;
constexpr int IN_DIM = 2944, DFF = 2816, NUP = 2 * DFF;
constexpr int NCHUNK = MT / 128;
constexpr int C_POOL = 0, C_NQ = 256, C_NK = 640, C_NV = 1024, C_RQ = 1408, C_RK = 1792, C_RV = 2176, C_GT = 2560;

constexpr int IN_PAD = 3072, AY_ROWS = 16896, CTXB = 16386;
constexpr size_t WT_IN = 0, WT_OUT = (size_t)IN_PAD * D, WT_UP = WT_OUT + (size_t)D * D, WT_DOWN = WT_UP + (size_t)NUP * D;
constexpr size_t WT_LAYER = WT_DOWN + (size_t)D * DFF;
constexpr size_t OFF_BAR = 0;
constexpr size_t OFF_WT = 16384;
constexpr size_t OFF_H = OFF_WT + WT_LAYER * 2 * DEPTH;
constexpr size_t OFF_AY = OFF_H + (size_t)MT * D * 4;
constexpr size_t OFF_P = OFF_AY + (size_t)AY_ROWS * D * 2;
constexpr size_t OFF_NVT = OFF_P + (size_t)MT * IN_DIM * 2;
constexpr size_t OFF_RVT = OFF_NVT + (size_t)384 * MT * 2;
constexpr size_t OFF_RKF = OFF_RVT + (size_t)384 * MT * 2;
constexpr size_t OFF_RKB = OFF_RKF + (size_t)384 * MT * 2;
constexpr size_t OFF_US = OFF_RKB + (size_t)384 * MT * 2;
constexpr size_t OFF_MOD = OFF_US + (size_t)NCHUNK * 2 * 6 * 4096 * 4;
constexpr size_t OFF_ROPE = OFF_MOD + (size_t)DEPTH * 2 * 6 * D * 4;
constexpr size_t OFF_PART = OFF_ROPE + (size_t)256 * 16 * 2 * 4;
constexpr size_t WS_END = OFF_PART + (size_t)11 * 256 * 1024 * 4;

constexpr int NT = 512;
constexpr int GEMM_LDS = 131072;
constexpr int XB_OFF = 135168;
constexpr int CW_OFF = 136192;
constexpr int LDS_BYTES = CW_OFF + 8192;
constexpr int NPHASE = 2 + 9 * DEPTH;

struct Params {
    const float *x, *c, *ctx, *c_ctx, *w_mod, *b_mod, *norm1_g, *w_in, *pool_w, *pool_scale, *na_rpb, *dec_f, *dec_b, *gn_g,
        *w_out, *norm2_g, *w_up, *conv_w, *conv_b, *w_down, *final_g;
    float* out;
    unsigned char* ws;
    int ph_lo, ph_hi;
};

__device__ __forceinline__ float bf2f(unsigned b) { return __uint_as_float(b << 16); }
__device__ __forceinline__ unsigned pack_bf16(float lo, float hi) {
    unsigned r;
    asm("v_cvt_pk_bf16_f32 %0, %1, %2" : "=v"(r) : "v"(lo), "v"(hi));
    return r;
}
__device__ __forceinline__ uint2 pack4(float a, float b, float c, float d) { return make_uint2(pack_bf16(a, b), pack_bf16(c, d)); }
__device__ __forceinline__ f32x4 mfma16(bf16x8 a, bf16x8 b, f32x4 c) { return __builtin_amdgcn_mfma_f32_16x16x32_bf16(a, b, c, 0, 0, 0); }
__device__ __forceinline__ bf16x8 mk8(uint2 lo, uint2 hi) {
    uint4 u = make_uint4(lo.x, lo.y, hi.x, hi.y);
    return *reinterpret_cast<bf16x8*>(&u);
}
__device__ __forceinline__ float silu_f(float v) { return v * __builtin_amdgcn_rcpf(1.f + __expf(-v)); }
__device__ __forceinline__ int brow(int t) { return t < LAT ? t + 1 : t + 3; }

#define PIN8(a, b, c, d, e, f, g, h) asm volatile("" : "+v"(a), "+v"(b), "+v"(c), "+v"(d), "+v"(e), "+v"(f), "+v"(g), "+v"(h) :: "memory")
__device__ __forceinline__ int opaque_tid() {
    int t = threadIdx.x;
    asm volatile("" : "+v"(t));
    return t;
}

#define XB_TMO 128
#define XB_XCNT(j) (256 + 64 * (j))
#define XB_XSUB(j) (1280 + 64 * (j))
#define XB_XGEN(j) (2304 + 64 * (j))
#define XB_TOP 3328
#define XB_TOPGEN 3392
#define XCD_BAR_WORDS 3456
#define XB_SPIN_CAP (1u << 22)
#define LAS __attribute__((address_space(3)))
__device__ __forceinline__ unsigned xb_ld(unsigned* p) { return __hip_atomic_load(p, __ATOMIC_RELAXED, __HIP_MEMORY_SCOPE_AGENT); }
__device__ __forceinline__ unsigned xb_add(unsigned* p, unsigned v) { return __hip_atomic_fetch_add(p, v, __ATOMIC_RELAXED, __HIP_MEMORY_SCOPE_AGENT); }
__device__ __forceinline__ unsigned xb_xcc_id() { return (unsigned)__builtin_amdgcn_s_getreg((3 << 11) | 20) & 0xFu; }
#define XB_SPIN(cond, bar)                                                                 \
    do {                                                                                   \
        unsigned _sp = 0;                                                                  \
        while (cond) {                                                                     \
            __builtin_amdgcn_s_sleep(1);                                                   \
            if ((++_sp & 255u) == 0u) {                                                    \
                if (xb_ld(&(bar)[XB_TMO])) break;                                          \
                if (_sp > XB_SPIN_CAP) { atomicAdd(&(bar)[XB_TMO], 1u); break; }           \
            }                                                                              \
        }                                                                                  \
    } while (0)
struct XcdBarrier { unsigned* bar; unsigned x; volatile LAS unsigned* st; };
__device__ __forceinline__ XcdBarrier xcd_barrier_post(unsigned* bar, volatile LAS unsigned* st) {
    XcdBarrier b; b.bar = bar; b.x = xb_xcc_id(); b.st = st;
    if (threadIdx.x == 0) (void)xb_add(&bar[XB_XCNT(b.x)], 1u);
    return b;
}
__device__ __forceinline__ void xcd_barrier_complete(unsigned* bar, unsigned x, unsigned& nloc, unsigned& nx) {
    const unsigned G = gridDim.x * gridDim.y * gridDim.z;
    unsigned sum, cnt, mine, sp = 0u;
    for (;;) {
        sum = 0u; cnt = 0u; mine = 0u;
#pragma unroll
        for (unsigned j = 0; j < 16; ++j) { const unsigned c = xb_ld(&bar[XB_XCNT(j)]); sum += c; cnt += (c > 0u) ? 1u : 0u; mine = (j == x) ? c : mine; }
        if (sum == G) break;
        __builtin_amdgcn_s_sleep(1);
        if ((++sp & 255u) == 0u) { if (xb_ld(&bar[XB_TMO])) break; if (sp > XB_SPIN_CAP) { atomicAdd(&bar[XB_TMO], 1u); break; } }
    }
    nloc = mine > 0u ? mine : 1u; nx = cnt > 0u ? cnt : 1u;
}
__device__ __forceinline__ void xcd_barrier(const XcdBarrier& b) {
    asm volatile("s_waitcnt vmcnt(0)" ::: "memory");
    __syncthreads();
    if (threadIdx.x == 0) {
        unsigned* bar = b.bar;
        __builtin_amdgcn_s_waitcnt(0);
        unsigned nloc = b.st[0], nx = b.st[1];
        if (nloc == 0u) { xcd_barrier_complete(bar, b.x, nloc, nx); b.st[0] = nloc; b.st[1] = nx; }
        const unsigned old = xb_add(&bar[XB_XSUB(b.x)], 1u);
        const unsigned gen = old / nloc;
        if (old + 1u == (gen + 1u) * nloc) {
            __builtin_amdgcn_fence(__ATOMIC_RELEASE, "agent");
            asm volatile("s_waitcnt vmcnt(0)" ::: "memory");
            const unsigned og = xb_add(&bar[XB_TOP], 1u);
            const unsigned tg = og / nx;
            if (og + 1u == (tg + 1u) * nx) xb_add(&bar[XB_TOPGEN], 1u);
            else XB_SPIN(xb_ld(&bar[XB_TOPGEN]) == tg, bar);
            __builtin_amdgcn_fence(__ATOMIC_ACQUIRE, "agent");
            xb_add(&bar[XB_XGEN(b.x)], 1u);
            asm volatile("s_waitcnt vmcnt(0)" ::: "memory");
        } else {
            XB_SPIN(xb_ld(&bar[XB_XGEN(b.x)]) == gen, bar);
            __builtin_amdgcn_fence(__ATOMIC_ACQUIRE, "agent");
            asm volatile("s_waitcnt vmcnt(0)" ::: "memory");
        }
    }
    __syncthreads();
}

__device__ void conv_weight_tile(const float* __restrict__ src, int N, bf16_t* __restrict__ dst, int K, int k0, int n0, int dst_row0, bool up_perm, float* lds, int tid) {
    f32x4 v[4];
#pragma unroll
    for (int i = 0; i < 4; ++i) v[i] = __builtin_nontemporal_load((const f32x4*)(src + (size_t)(k0 + (tid >> 4) + 16 * i) * N + n0 + (tid & 15) * 4));
    asm volatile("" : "+v"(v[0]), "+v"(v[1]), "+v"(v[2]), "+v"(v[3]) :: "memory");
#pragma unroll
    for (int i = 0; i < 4; ++i) {
        float* p = lds + ((tid >> 4) + 16 * i) * 65 + (tid & 15) * 4;
        p[0] = v[i][0]; p[1] = v[i][1]; p[2] = v[i][2]; p[3] = v[i][3];
    }
    __syncthreads();
    const int nn = tid >> 2, ks = (tid & 3) * 16;
    unsigned w[8];
#pragma unroll
    for (int j = 0; j < 8; ++j) w[j] = pack_bf16(lds[(ks + 2 * j) * 65 + nn], lds[(ks + 2 * j + 1) * 65 + nn]);
    int drow = dst_row0 + nn;
    if (up_perm) {
        const int half = n0 >= DFF ? 1 : 0, ff = n0 - half * DFF + nn;
        drow = 32 * (ff >> 4) + 16 * half + (ff & 15);
    }
    uint4* d = (uint4*)(dst + (size_t)drow * K + k0 + ks);
    d[0] = make_uint4(w[0], w[1], w[2], w[3]);
    d[1] = make_uint4(w[4], w[5], w[6], w[7]);
    __syncthreads();
}

constexpr int CONV_PER_LAYER = 736 + 256 + 1408 + 704;
__device__ __forceinline__ void conv_layer_item(const Params& p, int l, int r, float* lds, int tid) {
    bf16_t* wl = (bf16_t*)(p.ws + OFF_WT) + (size_t)l * WT_LAYER;
    if (r < 736) {
        const int kt = r / 46, nt = r % 46;
        conv_weight_tile(p.w_in + (size_t)l * D * IN_DIM, IN_DIM, wl + WT_IN, D, kt * 64, nt * 64, nt * 64, false, lds, tid);
    } else if (r < 736 + 256) {
        r -= 736;
        const int kt = r / 16, nt = r % 16;
        conv_weight_tile(p.w_out + (size_t)l * D * D, D, wl + WT_OUT, D, kt * 64, nt * 64, nt * 64, false, lds, tid);
    } else if (r < 736 + 256 + 1408) {
        r -= 736 + 256;
        const int kt = r / 88, nt = r % 88;
        conv_weight_tile(p.w_up + (size_t)l * D * NUP, NUP, wl + WT_UP, D, kt * 64, nt * 64, 0, true, lds, tid);
    } else {
        r -= 736 + 256 + 1408;
        const int kt = r / 16, nt = r % 16;
        conv_weight_tile(p.w_down + (size_t)l * DFF * D, D, wl + WT_DOWN, DFF, kt * 64, nt * 64, nt * 64, false, lds, tid);
    }
}

__device__ __forceinline__ void phase_prep(const Params& p, float* lds_all) {
    const int tid_all = opaque_tid(), half = tid_all >> 8, tid = tid_all & 255;
    float* lds = lds_all + half * 8192;
    constexpr int REST = CONV_PER_LAYER - 1408;
    constexpr int NW = CONV_PER_LAYER + (DEPTH - 1) * REST;
    constexpr int NMOD = DEPTH * 96;
    for (int it0 = blockIdx.x * 2; it0 < NW + NMOD; it0 += gridDim.x * 2) {
        const int it = it0 + half;
        if (it < NW) {
            if (it < CONV_PER_LAYER) conv_layer_item(p, 0, it, lds, tid);
            else {
                const int e = it - CONV_PER_LAYER, l = 1 + e / REST, r = e % REST;
                conv_layer_item(p, l, r < 992 ? r : r + 1408, lds, tid);
            }
        } else {
            const int mi = it - NW, l = mi / 96, col0 = (mi % 96) * 64;
            float* sx = lds;
            float* sc = lds + 1024;
            float* red = lds + 2048;
            for (int k = tid; k < 1024; k += 256) { sx[k] = silu_f(p.c[k]); sc[k] = silu_f(p.c_ctx[k]); }
            __syncthreads();
            const int kq = tid >> 4, cq = tid & 15;
            float ax[4] = {0.f, 0.f, 0.f, 0.f}, ac[4] = {0.f, 0.f, 0.f, 0.f};
            const float* wp = p.w_mod + ((size_t)l * 1024 + kq * 64) * 6144 + col0 + cq * 4;
            for (int k0 = 0; k0 < 64; k0 += 16) {
                f32x4 w4[16];
#pragma unroll
                for (int k = 0; k < 16; ++k) w4[k] = __builtin_nontemporal_load((const f32x4*)(wp + (size_t)(k0 + k) * 6144));
                PIN8(w4[0], w4[1], w4[2], w4[3], w4[4], w4[5], w4[6], w4[7]);
                PIN8(w4[8], w4[9], w4[10], w4[11], w4[12], w4[13], w4[14], w4[15]);
#pragma unroll
                for (int k = 0; k < 16; ++k) {
                    const float a = sx[kq * 64 + k0 + k], b = sc[kq * 64 + k0 + k];
                    ax[0] += a * w4[k][0]; ax[1] += a * w4[k][1]; ax[2] += a * w4[k][2]; ax[3] += a * w4[k][3];
                    ac[0] += b * w4[k][0]; ac[1] += b * w4[k][1]; ac[2] += b * w4[k][2]; ac[3] += b * w4[k][3];
                }
            }
#pragma unroll
            for (int j = 0; j < 4; ++j) { red[(kq * 64 + cq * 4 + j) * 2] = ax[j]; red[(kq * 64 + cq * 4 + j) * 2 + 1] = ac[j]; }
            __syncthreads();
            if (tid < 128) {
                const int col = tid >> 1, which = tid & 1;
                float s = 0.f;
#pragma unroll
                for (int q = 0; q < 16; ++q) s += red[(q * 64 + col) * 2 + which];
                float* mod = (float*)(p.ws + OFF_MOD);
                mod[((size_t)l * 2 + which) * 6144 + col0 + col] = s + p.b_mod[(size_t)l * 6144 + col0 + col];
            }
            __syncthreads();
        }
    }
    float* rope = (float*)(p.ws + OFF_ROPE);
    for (int i = blockIdx.x * NT + tid_all; i < 4096; i += gridDim.x * NT) {
        const int pos = i >> 4, d = i & 15;
        const float inv = powf(10000.f, -(float)d / 16.f);
        const float ang = (float)pos * inv;
        rope[i] = cosf(ang);
        rope[4096 + i] = sinf(ang);
    }
    {
        uint4* ay = (uint4*)(p.ws + OFF_AY);
        const int i = blockIdx.x * NT + tid_all;
        if (i < 512) {
            const int which = i >> 7, rr = which == 0 ? 0 : (which == 1 ? LAT + 1 : (which == 2 ? CTXB : CTXB + 257));
            ay[(size_t)rr * 128 + (i & 127)] = make_uint4(0u, 0u, 0u, 0u);
        }
    }
}

__device__ __forceinline__ void phase_norm(const Params& p, int l, const float* g, int shift_idx, int nrows, int npart) {
    const int tid = opaque_tid(), lane = tid & 63, wave = tid >> 6;
    const int gw = blockIdx.x * 8 + wave, nw = gridDim.x * 8;
    float* h = (float*)(p.ws + OFF_H);
    bf16_t* out = (bf16_t*)(p.ws + OFF_AY);
    const float* mod = (const float*)(p.ws + OFF_MOD) + (size_t)l * 2 * 6144 + shift_idx * D;
    {
        const float* src = (l == 0 && shift_idx == 0) ? p.x : h;
        f32x4 mul[4], add[4];
#pragma unroll
        for (int i = 0; i < 4; ++i) {
            const int col = i * 256 + lane * 4;
            mul[i] = *(const f32x4*)(g + col) * (*(const f32x4*)(mod + D + col) + 1.f);
            add[i] = *(const f32x4*)(mod + col);
        }
        for (int row0 = gw; row0 < LAT; row0 += 4 * nw) {
            f32x4 v[4][4];
#pragma unroll
            for (int k = 0; k < 4; ++k) {
                const int row = row0 + k * nw < LAT ? row0 + k * nw : row0;
#pragma unroll
                for (int i = 0; i < 4; ++i) v[k][i] = *(const f32x4*)(src + (size_t)row * D + i * 256 + lane * 4);
            }
            PIN8(v[0][0], v[0][1], v[0][2], v[0][3], v[1][0], v[1][1], v[1][2], v[1][3]);
            PIN8(v[2][0], v[2][1], v[2][2], v[2][3], v[3][0], v[3][1], v[3][2], v[3][3]);
#pragma unroll
            for (int k = 0; k < 4; ++k) {
                const int row = row0 + k * nw;
                if (row < LAT) {
                    float ss = 0.f;
#pragma unroll
                    for (int i = 0; i < 4; ++i) ss += v[k][i][0] * v[k][i][0] + v[k][i][1] * v[k][i][1] + v[k][i][2] * v[k][i][2] + v[k][i][3] * v[k][i][3];
#pragma unroll
                    for (int o = 32; o >= 1; o >>= 1) ss += __shfl_xor(ss, o);
                    const float r = rsqrtf(ss * (1.f / D) + 1e-6f);
#pragma unroll
                    for (int i = 0; i < 4; ++i) {
                        const f32x4 o = v[k][i] * r * mul[i] + add[i];
                        *(uint2*)(out + (size_t)(row + 1) * D + i * 256 + lane * 4) = pack4(o[0], o[1], o[2], o[3]);
                    }
                }
            }
        }
    }
    for (int row = LAT + gw; row < nrows; row += nw) {
        const float* hr = l == 0 ? p.ctx + (size_t)(row - LAT) * D : h + (size_t)row * D;
        const float* md = mod + 6144;
        f32x4 v[4];
#pragma unroll
        for (int i = 0; i < 4; ++i) v[i] = *(const f32x4*)(hr + i * 256 + lane * 4);
        if (npart > 0) {
            const float* pr = (const float*)(p.ws + OFF_PART) + (size_t)(row - LAT) * D;
            for (int s0 = 0; s0 < npart; s0 += 4) {
                f32x4 a[4][4];
#pragma unroll
                for (int s = 0; s < 4; ++s)
#pragma unroll
                    for (int i = 0; i < 4; ++i) a[s][i] = *(const f32x4*)(pr + (size_t)(s0 + s < npart ? s0 + s : npart - 1) * 256 * D + i * 256 + lane * 4);
                PIN8(a[0][0], a[0][1], a[0][2], a[0][3], a[1][0], a[1][1], a[1][2], a[1][3]);
                PIN8(a[2][0], a[2][1], a[2][2], a[2][3], a[3][0], a[3][1], a[3][2], a[3][3]);
#pragma unroll
                for (int s = 0; s < 4; ++s)
                    if (s0 + s < npart) {
#pragma unroll
                        for (int i = 0; i < 4; ++i) v[i] += a[s][i];
                    }
            }
#pragma unroll
            for (int i = 0; i < 4; ++i) *(f32x4*)(h + (size_t)row * D + i * 256 + lane * 4) = v[i];
        }
        float ss = 0.f;
#pragma unroll
        for (int i = 0; i < 4; ++i) ss += v[i][0] * v[i][0] + v[i][1] * v[i][1] + v[i][2] * v[i][2] + v[i][3] * v[i][3];
#pragma unroll
        for (int o = 32; o >= 1; o >>= 1) ss += __shfl_xor(ss, o);
        const float r = rsqrtf(ss * (1.f / D) + 1e-6f);
#pragma unroll
        for (int i = 0; i < 4; ++i) {
            const int col = i * 256 + lane * 4;
            const f32x4 o = v[i] * r * *(const f32x4*)(g + col) * (*(const f32x4*)(md + D + col) + 1.f) + *(const f32x4*)(md + col);
            *(uint2*)(out + (size_t)brow(row) * D + col) = pack4(o[0], o[1], o[2], o[3]);
        }
    }
}

__device__ __forceinline__ void phase_final(const Params& p) {
    const int tid = opaque_tid(), lane = tid & 63, wave = tid >> 6;
    const int gw = blockIdx.x * 8 + wave, nw = gridDim.x * 8;
    const float* h = (const float*)(p.ws + OFF_H);
    f32x4 gg[4];
#pragma unroll
    for (int i = 0; i < 4; ++i) gg[i] = *(const f32x4*)(p.final_g + i * 256 + lane * 4);
    for (int row0 = gw; row0 < LAT; row0 += 4 * nw) {
        f32x4 v[4][4];
#pragma unroll
        for (int k = 0; k < 4; ++k) {
            const int row = row0 + k * nw < LAT ? row0 + k * nw : row0;
#pragma unroll
            for (int i = 0; i < 4; ++i) v[k][i] = __builtin_nontemporal_load((const f32x4*)(h + (size_t)row * D + i * 256 + lane * 4));
        }
        PIN8(v[0][0], v[0][1], v[0][2], v[0][3], v[1][0], v[1][1], v[1][2], v[1][3]);
        PIN8(v[2][0], v[2][1], v[2][2], v[2][3], v[3][0], v[3][1], v[3][2], v[3][3]);
#pragma unroll
        for (int k = 0; k < 4; ++k) {
            const int row = row0 + k * nw;
            if (row < LAT) {
                float ss = 0.f;
#pragma unroll
                for (int i = 0; i < 4; ++i) ss += v[k][i][0] * v[k][i][0] + v[k][i][1] * v[k][i][1] + v[k][i][2] * v[k][i][2] + v[k][i][3] * v[k][i][3];
#pragma unroll
                for (int o = 32; o >= 1; o >>= 1) ss += __shfl_xor(ss, o);
                const float r = rsqrtf(ss * (1.f / D) + 1e-6f);
#pragma unroll
                for (int i = 0; i < 4; ++i) __builtin_nontemporal_store(v[k][i] * r * gg[i], (f32x4*)(p.out + (size_t)row * D + i * 256 + lane * 4));
            }
        }
    }
}

constexpr int BK = 64, HALF = 128, HTB = HALF * BK * 2, NXCD = 8, WGM = 8;
__device__ __forceinline__ int lds_byte(int r, int c) { const int st = (r >> 4) * 2 + (c >> 5), rr = r & 15, cc = c & 31, ob = rr * 64 + cc * 2; return st * 1024 + (ob ^ (((ob >> 9) & 1) << 5)); }
__device__ __forceinline__ void stage_rc(int b, int& R, int& C) { const int st = b / 1024, sb = b % 1024, swz = sb ^ (((sb >> 9) & 1) << 5); R = (st >> 1) * 16 + swz / 64; C = (st & 1) * 32 + (swz % 64) / 2; }
struct Unit { int pm, pn, k0, nt; };
struct StaticOrder {
    int nM, nN, nwg, G, c, ntf;
    int nx, xpm, xnt;
    __device__ void init(int nM_, int nN_, int K, int G_, int c_) { nM = nM_; nN = nN_; nwg = nM * nN; G = G_; c = c_; ntf = K / 64; nx = 0; xpm = 0; xnt = 4; }
    __device__ void split_extra(int pm, int xnt_) { xpm = pm; xnt = xnt_; nx = nN * (ntf / xnt_); }
    __device__ bool next(int i, Unit& u) const {
        const long L = (long)i * G + c; if (L >= nwg + nx) return false;
        if (L >= nwg) { const int e = (int)L - nwg; u.pm = xpm; u.pn = e % nN; u.k0 = (e / nN) * xnt * 64; u.nt = xnt; return true; }
        int wgid = (int)L; { const int q = nwg / NXCD, r = nwg % NXCD, xcd = wgid % NXCD, off = wgid / NXCD; wgid = (xcd < r ? xcd * (q + 1) : r * (q + 1) + (xcd - r) * q) + off; }
        const int nig = WGM * nN, gid = wgid / nig, fm = gid * WGM, gsz = (nM - fm) < WGM ? (nM - fm) : WGM;
        u.pm = fm + ((wgid % nig) % gsz); u.pn = (wgid % nig) / gsz; u.k0 = 0; u.nt = ntf; return true;
    }
};

template <class Epi>
__device__ __forceinline__ void gemm8(LAS unsigned char* lds, const bf16_t* A, int segstride, const bf16_t* Bt, int K, const StaticOrder& S, const Epi& E) {
    const int tid = opaque_tid(), wid = __builtin_amdgcn_readfirstlane(tid >> 6), lane = tid & 63, wr = wid >> 2, wc = wid & 3, fr = lane & 15, fq = lane >> 4;
    unsigned voffA[2], voffB[2];
#pragma unroll
    for (int i = 0; i < 2; ++i) { int R, C; stage_rc(tid * 16 + i * 8192, R, C);
        voffA[i] = (unsigned)(((R >> 6) * segstride + (R & 63)) * K + C) * 2u; voffB[i] = (unsigned)(R * K + C) * 2u; }
    const size_t kstep = (size_t)(BK * 2);
    const size_t hstepA = (size_t)(2 * segstride) * K * 2, hstepB = (size_t)HALF * K * 2;
    const unsigned ldsw = (unsigned)wid * 1024u;
    const int aoff = lds_byte(wr * 64 + fr, fq * 8), boff = lds_byte(wc * 32 + fr, fq * 8);
#define PG8_SA(b, h) (((b) * 2 + (h)) * HTB)
#define PG8_SB(b, h) ((4 + (b) * 2 + (h)) * HTB)
#define PG8_STAGE(bufoff, gbase, voff) do { _Pragma("unroll") for (int _i = 0; _i < 2; ++_i) \
        __builtin_amdgcn_global_load_lds((const unsigned*)((const char*)(gbase) + (voff)[_i]), (LAS unsigned*)(lds + (bufoff) + ldsw + _i * 8192), 16, 0, 0); } while (0)
#define PG8_LDA(dst, b, h) do { _Pragma("unroll") for (int m = 0; m < 4; ++m) _Pragma("unroll") for (int k = 0; k < 2; ++k) dst[m][k] = *(const LAS bf16x8*)(lds + PG8_SA(b, h) + aoff + m * 2048 + k * 1024); } while (0)
#define PG8_LDB(dst, b, h) do { _Pragma("unroll") for (int n = 0; n < 2; ++n) _Pragma("unroll") for (int k = 0; k < 2; ++k) dst[n][k] = *(const LAS bf16x8*)(lds + PG8_SB(b, h) + boff + n * 2048 + k * 1024); } while (0)
#define PG8_MMA(ai, bj, At, Bt_) do { __builtin_amdgcn_s_setprio(1); _Pragma("unroll") for (int m = 0; m < 4; ++m) _Pragma("unroll") for (int n = 0; n < 2; ++n) _Pragma("unroll") for (int k = 0; k < 2; ++k) \
        acc[ai][bj][m][n] = __builtin_amdgcn_mfma_f32_16x16x32_bf16(Bt_[n][k], At[m][k], acc[ai][bj][m][n], 0, 0, 0); __builtin_amdgcn_s_setprio(0); } while (0)
#define PG8_WAIT_V(n) asm volatile("s_waitcnt vmcnt(" #n ")" ::: "memory")
#define PG8_WAIT_L(n) asm volatile("s_waitcnt lgkmcnt(" #n ")" ::: "memory")
#define PG8_BAR __builtin_amdgcn_s_barrier()
#define PG8_SCHED __builtin_amdgcn_sched_barrier(0)
    Unit cur, nxt; int ui = 0;
    if (!S.next(0, cur)) return;
    f32x4 acc[2][2][4][2];
#pragma unroll
    for (int a = 0; a < 2; ++a)
#pragma unroll
        for (int b = 0; b < 2; ++b)
#pragma unroll
            for (int m = 0; m < 4; ++m)
#pragma unroll
                for (int n = 0; n < 2; ++n) acc[a][b][m][n] = (f32x4){0.f, 0.f, 0.f, 0.f};
    bf16x8 At[4][2], B0[2][2], B1[2][2];
    E.prefetch(cur, lds, wid, lane);
    const char* cA = (const char*)A + ((size_t)E.arow(cur.pm) * K + cur.k0) * 2; const char* cB = (const char*)Bt + ((size_t)cur.pn * 256 * K + cur.k0) * 2;
    PG8_STAGE(PG8_SB(0, 0), cB, voffB); PG8_STAGE(PG8_SA(0, 0), cA, voffA); PG8_STAGE(PG8_SB(0, 1), cB + hstepB, voffB); PG8_STAGE(PG8_SA(0, 1), cA + hstepA, voffA);
    if (wr == 1) PG8_BAR;
    PG8_WAIT_V(4); PG8_BAR;
    PG8_STAGE(PG8_SB(1, 0), cB + kstep, voffB); PG8_STAGE(PG8_SA(1, 0), cA + kstep, voffA); PG8_STAGE(PG8_SB(1, 1), cB + hstepB + kstep, voffB);
    PG8_WAIT_V(6); PG8_BAR;
    for (;;) {
        const bool has_next = S.next(ui + 1, nxt);
        const char* nA = has_next ? (const char*)A + ((size_t)E.arow(nxt.pm) * K + nxt.k0) * 2 : cA; const char* nB = has_next ? (const char*)Bt + ((size_t)nxt.pn * 256 * K + nxt.k0) * 2 : cB;
        const int nt = cur.nt;
        for (int t = 0; t < nt; t += 2) {
            const bool last = (t == nt - 2);
            const char* a1 = cA + (size_t)(t + 1) * kstep;
            const char* a2 = last ? nA : cA + (size_t)(t + 2) * kstep; const char* b2 = last ? nB : cB + (size_t)(t + 2) * kstep;
            const char* a3 = a2 + kstep; const char* b3 = b2 + kstep;
            PG8_LDB(B0, 0, 0); PG8_SCHED; PG8_LDA(At, 0, 0); PG8_STAGE(PG8_SA(1, 1), a1 + hstepA, voffA);
            PG8_WAIT_L(8); PG8_BAR; PG8_WAIT_L(0); PG8_MMA(0, 0, At, B0); PG8_BAR; PG8_SCHED;
            PG8_LDB(B1, 0, 1); PG8_STAGE(PG8_SB(0, 0), b2, voffB);
            PG8_BAR; PG8_WAIT_L(0); PG8_MMA(0, 1, At, B1); PG8_BAR;
            PG8_LDA(At, 0, 1); PG8_STAGE(PG8_SA(0, 0), a2, voffA);
            PG8_BAR; PG8_WAIT_L(0); PG8_MMA(1, 0, At, B0); PG8_BAR; PG8_SCHED;
            PG8_STAGE(PG8_SB(0, 1), b2 + hstepB, voffB);
            PG8_WAIT_V(6); PG8_BAR; PG8_MMA(1, 1, At, B1); PG8_BAR;
            PG8_LDB(B0, 1, 0); PG8_SCHED; PG8_LDA(At, 1, 0); PG8_STAGE(PG8_SA(0, 1), a2 + hstepA, voffA);
            PG8_WAIT_L(8); PG8_BAR; PG8_WAIT_L(0); PG8_MMA(0, 0, At, B0); PG8_BAR; PG8_SCHED;
            PG8_LDB(B1, 1, 1); PG8_STAGE(PG8_SB(1, 0), b3, voffB);
            PG8_BAR; PG8_WAIT_L(0); PG8_MMA(0, 1, At, B1); PG8_BAR;
            PG8_LDA(At, 1, 1); PG8_STAGE(PG8_SA(1, 0), a3, voffA);
            PG8_BAR; PG8_WAIT_L(0); PG8_MMA(1, 0, At, B0); PG8_BAR; PG8_SCHED;
            PG8_STAGE(PG8_SB(1, 1), b3 + hstepB, voffB);
            PG8_WAIT_V(6); PG8_BAR; PG8_MMA(1, 1, At, B1); PG8_BAR;
        }
        E(acc, cur, wr, wc, fr, fq, lds, wid);
        if (!has_next) break;
        E.prefetch(nxt, lds, wid, lane);
#pragma unroll
        for (int a = 0; a < 2; ++a)
#pragma unroll
            for (int b = 0; b < 2; ++b)
#pragma unroll
                for (int m = 0; m < 4; ++m)
#pragma unroll
                    for (int n = 0; n < 2; ++n) acc[a][b][m][n] = (f32x4){0.f, 0.f, 0.f, 0.f};
        cur = nxt; cA = nA; cB = nB; ++ui;
    }
    PG8_WAIT_V(0);
    if (wr == 0) PG8_BAR;
    PG8_BAR;
#undef PG8_SA
#undef PG8_SB
#undef PG8_STAGE
#undef PG8_LDA
#undef PG8_LDB
#undef PG8_MMA
#undef PG8_WAIT_V
#undef PG8_WAIT_L
#undef PG8_BAR
#undef PG8_SCHED
}

typedef f32x4 Acc8[2][2][4][2];

struct EpiInproj {
    const Params* p; int l;
    __device__ __forceinline__ int arow(int pm) const { return pm < 64 ? 1 + 256 * pm : CTXB + 1; }
    __device__ __forceinline__ void prefetch(const Unit&, LAS unsigned char*, int, int) const {}
    __device__ __forceinline__ void operator()(const Acc8& acc, const Unit& u, int wr, int wc, int fr, int fq, LAS unsigned char*, int) const {
        bf16_t* P = (bf16_t*)(p->ws + OFF_P);
        const float* rope = (const float*)(p->ws + OFF_ROPE);
        const int orow = u.pm * 256 + wr * 64 + fr;
#pragma unroll
        for (int bj = 0; bj < 2; ++bj) {
            const int cb = u.pn * 256 + bj * 128 + wc * 32;
            if (cb >= IN_DIM) continue;
            if ((cb >= C_NV && cb < C_RQ) || (cb >= C_RV && cb < C_GT)) {
                bf16_t* vt = (bf16_t*)(p->ws + (cb >= C_RV ? OFF_RVT : OFF_NVT));
                const int c0 = cb - (cb >= C_RV ? C_RV : C_NV) + fq * 4;
#pragma unroll
                for (int ai = 0; ai < 2; ++ai)
#pragma unroll
                    for (int m = 0; m < 4; ++m) {
                        const int row = orow + ai * 128 + m * 16;
#pragma unroll
                        for (int n = 0; n < 2; ++n)
#pragma unroll
                            for (int j = 0; j < 4; ++j) vt[(size_t)(c0 + n * 16 + j) * MT + row] = (bf16_t)(pack_bf16(acc[ai][bj][m][n][j], 0.f) & 0xffffu);
                    }
            } else if (cb >= C_RQ && cb < C_RV) {
                const bool is_rk = cb >= C_RK;
                const int hh = (cb - (is_rk ? C_RK : C_RQ)) >> 6;
                const bool colpart = (cb & 32) != 0;
                const float lgf = p->dec_f[l * 6 + hh], lgb = p->dec_b[l * 6 + hh];
                bf16_t* kf = (bf16_t*)(p->ws + OFF_RKF);
                bf16_t* kb = (bf16_t*)(p->ws + OFF_RKB);
                const float sc = is_rk ? 0.125f : 1.f;
#pragma unroll
                for (int ai = 0; ai < 2; ++ai) {
                    f32x4 tcs[4], tsn[4];
#pragma unroll
                    for (int m = 0; m < 4; ++m) {
                        const int row = orow + ai * 128 + m * 16, pos = row < LAT ? (colpart ? (row & 63) : (row >> 6)) : 0;
                        tcs[m] = *(const f32x4*)(rope + pos * 16 + fq * 4); tsn[m] = *(const f32x4*)(rope + 4096 + pos * 16 + fq * 4);
                    }
                    PIN8(tcs[0], tcs[1], tcs[2], tcs[3], tsn[0], tsn[1], tsn[2], tsn[3]);
#pragma unroll
                    for (int m = 0; m < 4; ++m) {
                        const int row = orow + ai * 128 + m * 16;
                        f32x4 v0 = acc[ai][bj][m][0], v1 = acc[ai][bj][m][1];
                        if (row < LAT) {
                            const f32x4 cs = tcs[m], sn = tsn[m];
                            const f32x4 o0 = v0 * cs - v1 * sn, o1 = v0 * sn + v1 * cs;
                            v0 = o0; v1 = o1;
                        }
                        v0 *= sc; v1 *= sc;
                        bf16_t* pr_ = P + (size_t)row * IN_DIM + cb + fq * 4;
                        *(uint2*)(pr_) = pack4(v0[0], v0[1], v0[2], v0[3]);
                        *(uint2*)(pr_ + 16) = pack4(v1[0], v1[1], v1[2], v1[3]);
                        if (is_rk) {
                            const int c = row & 127;
                            const float df = __expf((float)(127 - c) * lgf), db = __expf((float)c * lgb);
                            const int rb = (cb - C_RK) + fq * 4;
#pragma unroll
                            for (int j = 0; j < 4; ++j) {
                                const size_t o0 = (size_t)(rb + j) * MT + row, o1 = (size_t)(rb + 16 + j) * MT + row;
                                kf[o0] = (bf16_t)(pack_bf16(v0[j] * df, 0.f) & 0xffffu);
                                kb[o0] = (bf16_t)(pack_bf16(v0[j] * db, 0.f) & 0xffffu);
                                kf[o1] = (bf16_t)(pack_bf16(v1[j] * df, 0.f) & 0xffffu);
                                kb[o1] = (bf16_t)(pack_bf16(v1[j] * db, 0.f) & 0xffffu);
                            }
                        }
                    }
                }
            } else {
                const bool is_gate = cb >= C_GT, is_nq = cb >= C_NQ && cb < C_NK;
#pragma unroll
                for (int ai = 0; ai < 2; ++ai)
#pragma unroll
                    for (int m = 0; m < 4; ++m) {
                        const int row = orow + ai * 128 + m * 16;
#pragma unroll
                        for (int n = 0; n < 2; ++n) {
                            f32x4 v = acc[ai][bj][m][n];
                            if (is_nq) v *= 0.125f * 1.44269504f;
                            if (is_gate) { v[0] = silu_f(v[0]); v[1] = silu_f(v[1]); v[2] = silu_f(v[2]); v[3] = silu_f(v[3]); }
                            *(uint2*)(P + (size_t)row * IN_DIM + cb + n * 16 + fq * 4) = pack4(v[0], v[1], v[2], v[3]);
                        }
                    }
            }
        }
    }
};

struct EpiResid {
    float* h; float* part; const float* mod; bool a_is_ay; bool dry; const float* hsrc;
    __device__ __forceinline__ int arow(int pm) const { return a_is_ay ? (pm < 64 ? 1 + 256 * pm : CTXB + 1) : 256 * pm; }
    __device__ __forceinline__ void prefetch(const Unit&, LAS unsigned char*, int, int) const {}
    __device__ __forceinline__ void operator()(const Acc8& acc, const Unit& u, int wr, int wc, int fr, int fq, LAS unsigned char*, int) const {
        const bool split = u.pm >= 64;
        const float* gv = mod + (u.pm >= 64 ? 6144 : 0) + u.pn * 256 + wc * 32 + fq * 4;
        float* hb = h + (size_t)(u.pm * 256 + wr * 64 + fr) * D + u.pn * 256 + wc * 32 + fq * 4;
        const ptrdiff_t poff = split ? (part - h) + ((ptrdiff_t)(u.k0 >> 8) * 256 - LAT) * D : 0;
        const ptrdiff_t soff = hsrc - h;
#pragma unroll
        for (int bj = 0; bj < 2; ++bj) {
            const f32x4 g0 = *(const f32x4*)(gv + bj * 128) * (dry ? 0.f : 1.f), g1 = *(const f32x4*)(gv + bj * 128 + 16) * (dry ? 0.f : 1.f);
            if (split) {
#pragma unroll
                for (int ai = 0; ai < 2; ++ai)
#pragma unroll
                    for (int m = 0; m < 4; ++m) {
                        float* q = hb + (size_t)(ai * 128 + m * 16) * D + bj * 128 + poff;
                        *(f32x4*)q = g0 * acc[ai][bj][m][0];
                        *(f32x4*)(q + 16) = g1 * acc[ai][bj][m][1];
                    }
            } else {
                f32x4 hv[2][4][2];
#pragma unroll
                for (int ai = 0; ai < 2; ++ai)
#pragma unroll
                    for (int m = 0; m < 4; ++m) {
                        const float* q = hb + (size_t)(ai * 128 + m * 16) * D + bj * 128 + soff;
                        hv[ai][m][0] = *(const f32x4*)q; hv[ai][m][1] = *(const f32x4*)(q + 16);
                    }
                PIN8(hv[0][0][0], hv[0][0][1], hv[0][1][0], hv[0][1][1], hv[0][2][0], hv[0][2][1], hv[0][3][0], hv[0][3][1]);
                PIN8(hv[1][0][0], hv[1][0][1], hv[1][1][0], hv[1][1][1], hv[1][2][0], hv[1][2][1], hv[1][3][0], hv[1][3][1]);
#pragma unroll
                for (int ai = 0; ai < 2; ++ai)
#pragma unroll
                    for (int m = 0; m < 4; ++m) {
                        float* q = hb + (size_t)(ai * 128 + m * 16) * D + bj * 128;
                        *(f32x4*)q = hv[ai][m][0] + g0 * acc[ai][bj][m][0];
                        *(f32x4*)(q + 16) = hv[ai][m][1] + g1 * acc[ai][bj][m][1];
                    }
            }
        }
    }
};

template <int CTRL> __device__ __forceinline__ float dpp_mov(float v) { return __int_as_float(__builtin_amdgcn_update_dpp(0, __float_as_int(v), CTRL, 0xf, 0xf, false)); }
struct EpiUp {
    const float* cw; const float* cbias; bf16_t* G;
    __device__ __forceinline__ int arow(int pm) const { return pm < 67 ? 248 * pm : CTXB + 248 * (pm - 67); }
    __device__ __forceinline__ void prefetch(const Unit& u, LAS unsigned char* lds, int wid, int lane) const {
        const int vec = lane >> 3, bj = (lane >> 2) & 1, wc = wid & 3;
        const int ff = 16 * (u.pn * 8 + bj * 4 + wc) + (lane & 3) * 4;
        const float* src_ = ((vec & 3) == 3 ? cbias : cw + (vec & 3) * NUP) + (vec >= 4 ? DFF : 0) + ff;
        __builtin_amdgcn_global_load_lds((const unsigned*)src_, (LAS unsigned*)(lds + CW_OFF + wid * 1024), 16, 0, 0);
    }
    __device__ __forceinline__ void operator()(const Acc8& acc, const Unit& u, int wr, int wc, int fr, int fq, LAS unsigned char* lds, int wid) const {
        const bool isctx = u.pm >= 67;
        const int t0 = 248 * (isctx ? u.pm - 67 : u.pm), slen = isctx ? NCTX : LAT, sbase = isctx ? LAT : 0;
#pragma unroll
        for (int bj = 0; bj < 2; ++bj) {
            const int ff = 16 * (u.pn * 8 + bj * 4 + wc) + fq * 4;
            LAS const unsigned char* cl = lds + CW_OFF + wid * 1024 + (bj * 4 + fq) * 16;
            const f32x4 wa0 = *(LAS const f32x4*)(cl), wa1 = *(LAS const f32x4*)(cl + 128), wa2 = *(LAS const f32x4*)(cl + 256), ba = *(LAS const f32x4*)(cl + 384);
            const f32x4 wb0 = *(LAS const f32x4*)(cl + 512), wb1 = *(LAS const f32x4*)(cl + 640), wb2 = *(LAS const f32x4*)(cl + 768), bb = *(LAS const f32x4*)(cl + 896);
#pragma unroll
            for (int ai = 0; ai < 2; ++ai) {
                const int tseg = t0 + 62 * (2 * ai + wr) - 1;
                float pa[4], pb[4], ca[4], cb2[4];
#pragma unroll
                for (int j = 0; j < 4; ++j) { pa[j] = 0.f; pb[j] = 0.f; ca[j] = dpp_mov<0x12F>(acc[ai][bj][0][0][j]); cb2[j] = dpp_mov<0x12F>(acc[ai][bj][0][1][j]); }
#pragma unroll
                for (int m = 0; m < 4; ++m) {
                    const int r = 16 * m + fr, tl = tseg + r;
                    float o[4];
#pragma unroll
                    for (int j = 0; j < 4; ++j) {
                        const float a_c = acc[ai][bj][m][0][j], b_c = acc[ai][bj][m][1][j];
                        const float a1 = dpp_mov<0x121>(a_c), b1 = dpp_mov<0x121>(b_c);
                        const float na = m < 3 ? dpp_mov<0x12F>(acc[ai][bj][m < 3 ? m + 1 : 3][0][j]) : 0.f;
                        const float nb = m < 3 ? dpp_mov<0x12F>(acc[ai][bj][m < 3 ? m + 1 : 3][1][j]) : 0.f;
                        const float ap = fr == 0 ? pa[j] : a1, bp = fr == 0 ? pb[j] : b1;
                        const float an = fr == 15 ? na : ca[j], bn = fr == 15 ? nb : cb2[j];
                        const float ua = wa0[j] * ap + wa1[j] * a_c + wa2[j] * an + ba[j];
                        const float ub = wb0[j] * bp + wb1[j] * b_c + wb2[j] * bn + bb[j];
                        o[j] = silu_f(ua) * ub;
                        pa[j] = a1; pb[j] = b1; ca[j] = na; cb2[j] = nb;
                    }
                    if (r >= 1 && r <= 62 && tl < slen) *(uint2*)(G + (size_t)(sbase + tl) * DFF + ff) = pack4(o[0], o[1], o[2], o[3]);
                }
            }
        }
    }
};

__device__ __forceinline__ void phase_inproj(const Params& p, int l, unsigned char* lds) {
    StaticOrder S; S.init(65, IN_PAD / 256, D, gridDim.x, blockIdx.x);
    EpiInproj E; E.p = &p; E.l = l;
    gemm8((LAS unsigned char*)lds, (const bf16_t*)(p.ws + OFF_AY), 64, (const bf16_t*)(p.ws + OFF_WT) + (size_t)l * WT_LAYER + WT_IN, D, S, E);
    const int nfourth = 65 * (IN_PAD / 256) - 3 * (int)gridDim.x;
    if (l + 1 < DEPTH && nfourth > 0 && nfourth < (int)gridDim.x && (int)blockIdx.x >= nfourth) {
        const int tid_all = opaque_tid(), half = tid_all >> 8, tid = tid_all & 255;
        float* cl = (float*)lds + half * 8192;
        __syncthreads();
        for (int it0 = ((int)blockIdx.x - nfourth) * 2; it0 < 1408; it0 += ((int)gridDim.x - nfourth) * 2) conv_layer_item(p, l + 1, 992 + it0 + half, cl, tid);
    } else if (l + 1 < DEPTH && !(nfourth > 0 && nfourth < (int)gridDim.x)) {
        const int tid_all = opaque_tid(), half = tid_all >> 8, tid = tid_all & 255;
        float* cl = (float*)lds + half * 8192;
        __syncthreads();
        for (int it0 = (int)blockIdx.x * 2; it0 < 1408; it0 += (int)gridDim.x * 2) conv_layer_item(p, l + 1, 992 + it0 + half, cl, tid);
    }
}
__device__ __forceinline__ void phase_resid(const Params& p, int l, bool a_is_ay, const bf16_t* A, const bf16_t* Bt, int K, int gate_idx, int mtiles, unsigned char* lds) {
    StaticOrder S; S.init(64, 4, K, gridDim.x, blockIdx.x);
    if (mtiles > 64) S.split_extra(64, 4);
    EpiResid E; E.h = (float*)(p.ws + OFF_H); E.part = (float*)(p.ws + OFF_PART); E.mod = (const float*)(p.ws + OFF_MOD) + (size_t)l * 2 * 6144 + gate_idx * D; E.a_is_ay = a_is_ay;
    E.hsrc = (l == 0 && a_is_ay) ? p.x : (const float*)E.h;
    E.dry = false;
#if PROBE_DUP == 5 || PROBE_DUP == 8
    E.dry = (K == (PROBE_DUP == 5 ? D : DFF));
    if (E.dry) { gemm8((LAS unsigned char*)lds, A, 64, Bt, K, S, E); E.dry = false; __syncthreads(); }
#endif
    gemm8((LAS unsigned char*)lds, A, 64, Bt, K, S, E);
}
__device__ __forceinline__ void phase_up(const Params& p, int l, bool with_ctx, unsigned char* lds) {
    StaticOrder S; S.init(with_ctx ? 69 : 67, NUP / 256, D, gridDim.x, blockIdx.x);
    EpiUp E; E.cw = p.conv_w + (size_t)l * 3 * NUP; E.cbias = p.conv_b + (size_t)l * NUP; E.G = (bf16_t*)(p.ws + OFF_P);
    gemm8((LAS unsigned char*)lds, (const bf16_t*)(p.ws + OFF_AY), 62, (const bf16_t*)(p.ws + OFF_WT) + (size_t)l * WT_LAYER + WT_UP, D, S, E);
}

__device__ void pool_item(const Params& p, int l, int item, unsigned char* lds, int tid) {
    const int g = item & 3, tt = item >> 2;
    const int t0 = tt * 64;
    const int s0 = t0 < LAT ? 0 : LAT, s1 = t0 < LAT ? LAT : MT;
    const bf16_t* P = (const bf16_t*)(p.ws + OFF_P);
    bf16_t* Y = (bf16_t*)(p.ws + OFF_AY);
    float* pin = (float*)lds;
    bf16_t* dif = (bf16_t*)(lds + 20800);
    bf16_t* wT = (bf16_t*)(lds + 20800 + 9216);
    const float* wg = p.pool_w + ((size_t)l * 4 + g) * 4096;
    {
        typedef unsigned u32x4 __attribute__((ext_vector_type(4)));
        u32x4 pu[3];
        f32x4 w4[4];
#pragma unroll
        for (int k = 0; k < 3; ++k) {
            const int i = tid + 256 * k, rr = (i < 640 ? i : tid) >> 3, c8 = (i & 7) * 8;
            int tok = t0 - 8 + rr;
            tok = tok < s0 ? s0 : (tok >= s1 ? s1 - 1 : tok);
            pu[k] = *(const u32x4*)(P + (size_t)tok * IN_DIM + C_POOL + g * 64 + c8);
        }
#pragma unroll
        for (int k = 0; k < 4; ++k) w4[k] = *(const f32x4*)(wg + ((tid + 256 * k) >> 4) * 64 + ((tid + 256 * k) & 15) * 4);
        asm volatile("" : "+v"(pu[0]), "+v"(pu[1]), "+v"(pu[2]), "+v"(w4[0]), "+v"(w4[1]), "+v"(w4[2]), "+v"(w4[3]) :: "memory");
#pragma unroll
        for (int k = 0; k < 3; ++k) {
            const int i = tid + 256 * k;
            if (i < 640) {
                float* d = pin + (i >> 3) * 65 + (i & 7) * 8;
                d[0] = bf2f(pu[k][0] & 0xffffu); d[1] = bf2f(pu[k][0] >> 16); d[2] = bf2f(pu[k][1] & 0xffffu); d[3] = bf2f(pu[k][1] >> 16);
                d[4] = bf2f(pu[k][2] & 0xffffu); d[5] = bf2f(pu[k][2] >> 16); d[6] = bf2f(pu[k][3] & 0xffffu); d[7] = bf2f(pu[k][3] >> 16);
            }
        }
#pragma unroll
        for (int k = 0; k < 4; ++k) {
            const int i = tid + 256 * k, c = i >> 4, d4 = (i & 15) * 4;
            wT[(d4 + 0) * 72 + c] = (bf16_t)(pack_bf16(w4[k][0], 0.f) & 0xffffu);
            wT[(d4 + 1) * 72 + c] = (bf16_t)(pack_bf16(w4[k][1], 0.f) & 0xffffu);
            wT[(d4 + 2) * 72 + c] = (bf16_t)(pack_bf16(w4[k][2], 0.f) & 0xffffu);
            wT[(d4 + 3) * 72 + c] = (bf16_t)(pack_bf16(w4[k][3], 0.f) & 0xffffu);
        }
    }
    __syncthreads();
    {
        const int c = tid & 63, tq = tid >> 6, win = 2 << g;
        int t = t0 + tq * 16;
        int lo = t - win / 2, hi = lo + win;
        lo = lo < s0 ? s0 : lo;
        hi = hi > s1 ? s1 : hi;
        float s = 0.f;
        for (int u = lo; u < hi; ++u) s += pin[(u - t0 + 8) * 65 + c];
#pragma unroll 4
        for (int k = 0; k < 16; ++k) {
            dif[(tq * 16 + k) * 72 + c] = (bf16_t)(pack_bf16(s * __builtin_amdgcn_rcpf((float)(hi - lo)) - pin[(t - t0 + 8) * 65 + c], 0.f) & 0xffffu);
            ++t;
            int nlo = t - win / 2, nhi = nlo + win;
            nlo = nlo < s0 ? s0 : nlo;
            nhi = nhi > s1 ? s1 : nhi;
            if (nhi > hi) s += pin[(nhi - 1 - t0 + 8) * 65 + c];
            if (nlo > lo) s -= pin[(lo - t0 + 8) * 65 + c];
            lo = nlo; hi = nhi;
        }
    }
    __syncthreads();
    {
        const int lane = tid & 63, w = tid >> 6, fr = lane & 15, fq = lane >> 4;
        f32x4 acc[4];
#pragma unroll
        for (int dt = 0; dt < 4; ++dt) acc[dt] = (f32x4){0.f, 0.f, 0.f, 0.f};
#pragma unroll
        for (int ks = 0; ks < 2; ++ks) {
            const bf16x8 yf = *(const bf16x8*)(dif + (w * 16 + fr) * 72 + ks * 32 + fq * 8);
#pragma unroll
            for (int dt = 0; dt < 4; ++dt) {
                const bf16x8 xf = *(const bf16x8*)(wT + (dt * 16 + fr) * 72 + ks * 32 + fq * 8);
                acc[dt] = mfma16(xf, yf, acc[dt]);
            }
        }
        const float* sc = p.pool_scale + (size_t)l * 256 + g * 64;
#pragma unroll
        for (int dt = 0; dt < 4; ++dt) {
            const f32x4 s4 = *(const f32x4*)(sc + dt * 16 + fq * 4);
            *(uint2*)(Y + (size_t)brow(t0 + w * 16 + fr) * D + g * 64 + dt * 16 + fq * 4) =
                pack4(acc[dt][0] * s4[0], acc[dt][1] * s4[1], acc[dt][2] * s4[2], acc[dt][3] * s4[3]);
        }
    }
    __syncthreads();
}

__device__ void na_item(const Params& p, int item, const float* rpb  ) {
    const int lane = opaque_tid() & 63, fr = lane & 15, fq = lane >> 4;
    const bf16_t* P = (const bf16_t*)(p.ws + OFF_P);
    const bf16_t* NVt = (const bf16_t*)(p.ws + OFF_NVT);
    bf16_t* Y = (bf16_t*)(p.ws + OFF_AY);
    int h, q0, r = 0, n = 0, rs = 0, cs = 0, nloc;
    if (item < 6144) {
        h = item % 6;
        const int rn = item / 6;
        n = rn & 3; r = rn >> 2;
        q0 = r * 64 + n * 16;
        rs = r - 4; rs = rs < 0 ? 0 : (rs > 248 ? 248 : rs);
        cs = n * 16 - 8; cs = cs < 0 ? 0 : (cs > 32 ? 32 : cs);
        nloc = 8;
    } else {
        const int ci = item - 6144;
        h = ci % 6;
        q0 = LAT + (ci / 6) * 16;
        nloc = 0;
    }
    bf16x8 qf[2];
#pragma unroll
    for (int ks = 0; ks < 2; ++ks) qf[ks] = *(const bf16x8*)(P + (size_t)(q0 + fr) * IN_DIM + C_NQ + h * 64 + ks * 32 + fq * 8);
    f32x4 o[4];
#pragma unroll
    for (int dt = 0; dt < 4; ++dt) o[dt] = (f32x4){0.f, 0.f, 0.f, 0.f};
    float m = -1e30f, lsum = 0.f;
    const int qc = n * 16 + fr;
    int wsn = qc - 8; wsn = wsn < 0 ? 0 : (wsn > 48 ? 48 : wsn);
    const int nsteps = nloc + 8;
#pragma unroll 1
    for (int s = 0; s < nsteps; ++s) {
        const bool loc = s < nloc;
        const int tb = loc ? (rs + s) * 64 + cs : LAT + (s - nloc) * 32;
        f32x4 st[2];
#pragma unroll
        for (int kt = 0; kt < 2; ++kt) {
            const bf16_t* kp = P + (size_t)(tb + kt * 16 + fr) * IN_DIM + C_NK + h * 64 + fq * 8;
            const bf16x8 k0 = *(const bf16x8*)kp, k1 = *(const bf16x8*)(kp + 32);
            st[kt] = mfma16(k0, qf[0], (f32x4){0.f, 0.f, 0.f, 0.f});
            st[kt] = mfma16(k1, qf[1], st[kt]);
        }
        if (loc) {
            const float* rb = rpb + (h * 15 + (rs + s - r + 7)) * 31;
#pragma unroll
            for (int kt = 0; kt < 2; ++kt)
#pragma unroll
                for (int j = 0; j < 4; ++j) {
                    const int kcol = cs + kt * 16 + fq * 4 + j;
                    const bool valid = kcol >= wsn && kcol < wsn + 16;
                    int dc = kcol - qc + 15; dc = dc < 0 ? 0 : (dc > 30 ? 30 : dc);
                    st[kt][j] = valid ? st[kt][j] + rb[dc] : -1e30f;
                }
        }
        float mx = fmaxf(fmaxf(fmaxf(st[0][0], st[0][1]), fmaxf(st[0][2], st[0][3])), fmaxf(fmaxf(st[1][0], st[1][1]), fmaxf(st[1][2], st[1][3])));
        mx = fmaxf(mx, __shfl_xor(mx, 16));
        mx = fmaxf(mx, __shfl_xor(mx, 32));
        const float mn = fmaxf(m, mx);
        const float alpha = __expf(m - mn);
        m = mn;
        float pv[8], ps = 0.f;
#pragma unroll
        for (int kt = 0; kt < 2; ++kt)
#pragma unroll
            for (int j = 0; j < 4; ++j) { pv[kt * 4 + j] = __expf(st[kt][j] - mn); ps += pv[kt * 4 + j]; }
        lsum = lsum * alpha + ps;
        const uint4 pu = make_uint4(pack_bf16(pv[0], pv[1]), pack_bf16(pv[2], pv[3]), pack_bf16(pv[4], pv[5]), pack_bf16(pv[6], pv[7]));
        const bf16x8 pf = *reinterpret_cast<const bf16x8*>(&pu);
#pragma unroll
        for (int dt = 0; dt < 4; ++dt) {
            const bf16_t* vp = NVt + (size_t)(h * 64 + dt * 16 + fr) * MT + tb + fq * 4;
            const bf16x8 vf = mk8(*(const uint2*)vp, *(const uint2*)(vp + 16));
            o[dt] *= alpha;
            o[dt] = mfma16(vf, pf, o[dt]);
        }
    }
    lsum += __shfl_xor(lsum, 16);
    lsum += __shfl_xor(lsum, 32);
    const float il = 1.f / lsum;
#pragma unroll
    for (int dt = 0; dt < 4; ++dt)
        *(uint2*)(Y + (size_t)brow(q0 + fr) * D + 256 + h * 64 + dt * 16 + fq * 4) = pack4(o[dt][0] * il, o[dt][1] * il, o[dt][2] * il, o[dt][3] * il);
}

constexpr int NA_CK = 0, NA_CV = 32768, NA_RING = 65536, NA_RPB = 131072;
struct NaState { f32x4 o[4]; float m, l; bf16x8 q[2]; };

template <bool LOC>
__device__ __forceinline__ void na_step_lds(NaState& s, LAS const unsigned char* kbase, int key0, LAS const unsigned char* vbase, int vstride, int tok0,
                                            LAS const float* rb, int cs, int qc, int wsn, int fr, int fq) {
    f32x4 st[2];
#pragma unroll
    for (int kt = 0; kt < 2; ++kt) {
        const int kk = key0 + 8 * (fr >> 2) + 4 * kt + (fr & 3);
        LAS const unsigned char* ka = kbase + kk * 128;
        const bf16x8 k0 = *(LAS const bf16x8*)(ka + ((fq ^ (kk & 7)) << 4));
        const bf16x8 k1 = *(LAS const bf16x8*)(ka + (((4 + fq) ^ (kk & 7)) << 4));
        st[kt] = mfma16(k0, s.q[0], (f32x4){0.f, 0.f, 0.f, 0.f});
        st[kt] = mfma16(k1, s.q[1], st[kt]);
    }
    if (LOC) {
#pragma unroll
        for (int kt = 0; kt < 2; ++kt)
#pragma unroll
            for (int j = 0; j < 4; ++j) {
                const int kcol = cs + 8 * fq + 4 * kt + j;
                const bool valid = kcol >= wsn && kcol < wsn + 16;
                int dc = kcol - qc + 15; dc = dc < 0 ? 0 : (dc > 30 ? 30 : dc);
                const float bias = rb[dc];
                st[kt][j] = valid ? st[kt][j] + bias : -1e30f;
            }
    }
    float mx = fmaxf(fmaxf(fmaxf(st[0][0], st[0][1]), fmaxf(st[0][2], st[0][3])), fmaxf(fmaxf(st[1][0], st[1][1]), fmaxf(st[1][2], st[1][3])));
    mx = fmaxf(mx, __shfl_xor(mx, 16));
    mx = fmaxf(mx, __shfl_xor(mx, 32));
    const float mn = fmaxf(s.m, mx);
    const float alpha = __builtin_amdgcn_exp2f(s.m - mn);
    s.m = mn;
    float pv[8], ps = 0.f;
#pragma unroll
    for (int kt = 0; kt < 2; ++kt)
#pragma unroll
        for (int j = 0; j < 4; ++j) { pv[kt * 4 + j] = __builtin_amdgcn_exp2f(st[kt][j] - mn); ps += pv[kt * 4 + j]; }
    s.l = s.l * alpha + ps;
    const uint4 pu = make_uint4(pack_bf16(pv[0], pv[1]), pack_bf16(pv[2], pv[3]), pack_bf16(pv[4], pv[5]), pack_bf16(pv[6], pv[7]));
    const bf16x8 pf = *reinterpret_cast<const bf16x8*>(&pu);
    const int chunk = (tok0 >> 3) + fq;
#pragma unroll
    for (int dt = 0; dt < 4; ++dt) {
        const int d = dt * 16 + fr;
        const bf16x8 vf = *(LAS const bf16x8*)(vbase + d * vstride + ((chunk ^ (d & 7)) << 4));
        s.o[dt] *= alpha;
        s.o[dt] = mfma16(vf, pf, s.o[dt]);
    }
}

__device__ __forceinline__ void phase_na(const Params& p, int l, bool with_ctx, unsigned char* lds_g) {
    LAS unsigned char* lds = (LAS unsigned char*)lds_g;
    const int tid = opaque_tid(), wave = __builtin_amdgcn_readfirstlane(tid >> 6), lane = tid & 63, fr = lane & 15, fq = lane >> 4;
    const int G = gridDim.x, b = blockIdx.x;
    const int h = b % 6, idx = b / 6, nblk = (G - h + 5) / 6;
    const int r_lo = idx * 256 / nblk, r_hi = (idx + 1) * 256 / nblk, nst = (r_hi - r_lo) * 4;
    const bf16_t* P = (const bf16_t*)(p.ws + OFF_P);
    const bf16_t* Kg = P + C_NK + h * 64;
    const bf16_t* Vg = (const bf16_t*)(p.ws + OFF_NVT) + (size_t)(h * 64) * MT;
    bf16_t* Y = (bf16_t*)(p.ws + OFF_AY);
    LAS float* rpb = (LAS float*)(lds + NA_RPB);
    for (int i = tid; i < 465; i += NT) rpb[i] = p.na_rpb[((size_t)l * 6 + h) * 465 + i] * 1.44269504f;
#define NA_GLDS(gptr, loff) __builtin_amdgcn_global_load_lds((const unsigned*)(gptr), (LAS unsigned*)(lds + (loff)), 16, 0, 0)
    const bool has_cx = with_ctx && idx < 16;
    NaState st[4];
    int sr[4], snb[4];
    bool sv[4], sx[4];
#pragma unroll
    for (int si = 0; si < 4; ++si) {
        const int g = wave + 8 * si;
        sx[si] = has_cx && g == nst;
        sv[si] = g < nst || sx[si];
        sr[si] = r_lo + (g >> 2); snb[si] = g & 3;
        const int q0 = sx[si] ? LAT + idx * 16 : (sv[si] ? sr[si] : r_lo) * 64 + snb[si] * 16;
#pragma unroll
        for (int ks = 0; ks < 2; ++ks) st[si].q[ks] = *(const bf16x8*)(P + (size_t)(q0 + fr) * IN_DIM + C_NQ + h * 64 + ks * 32 + fq * 8);
#pragma unroll
        for (int dt = 0; dt < 4; ++dt) st[si].o[dt] = (f32x4){0.f, 0.f, 0.f, 0.f};
        st[si].m = -1e30f; st[si].l = 0.f;
        asm volatile("" : "+v"(st[si].q[0]), "+v"(st[si].q[1]));
    }
#pragma unroll
    for (int i = 0; i < 4; ++i) {
        const int q = wave * 4 + i, s = q * 64 + lane, key = s >> 3, ch = (s & 7) ^ (key & 7);
        NA_GLDS(Kg + (size_t)(LAT + key) * IN_DIM + ch * 8, NA_CK + q * 1024);
    }
#pragma unroll
    for (int i = 0; i < 4; ++i) {
        const int q = wave * 4 + i, s = q * 64 + lane, d = s >> 5, ch = (s & 31) ^ (d & 7);
        NA_GLDS(Vg + (size_t)d * MT + LAT + ch * 8, NA_CV + q * 1024);
    }
    int kr_lo = r_lo - 4; kr_lo = kr_lo < 0 ? 0 : (kr_lo > 248 ? 248 : kr_lo);
    int kr_hi = r_hi - 1 - 4; kr_hi = (kr_hi < 0 ? 0 : (kr_hi > 248 ? 248 : kr_hi)) + 7;
    const int srow = wave * 64 + lane, scol = srow >> 3, sch = (srow & 7) ^ (scol & 7);
    const bf16_t* kst = Kg + (size_t)scol * IN_DIM + sch * 8;
    const bf16_t* vst = Vg + (size_t)scol * MT + sch * 8;
#define NA_STAGE(kr_, slot_) do { const int _kr = (kr_) > kr_hi ? kr_hi : (kr_); \
        NA_GLDS(kst + (size_t)_kr * 64 * IN_DIM, NA_RING + (slot_) * 16384 + wave * 1024); \
        NA_GLDS(vst + _kr * 64, NA_RING + (slot_) * 16384 + 8192 + wave * 1024); } while (0)
    NA_STAGE(kr_lo, 0); NA_STAGE(kr_lo + 1, 1); NA_STAGE(kr_lo + 2, 2);
    for (int kr = kr_lo; kr <= kr_hi; ++kr) {
        const int j = kr - kr_lo;
        asm volatile("s_waitcnt vmcnt(4)" ::: "memory");
        __builtin_amdgcn_s_barrier();
        asm volatile("" ::: "memory");
        NA_STAGE(kr + 3, (j + 3) & 3);
        LAS const unsigned char* kb = lds + NA_RING + (j & 3) * 16384;
        bool act[4];
#pragma unroll
        for (int si = 0; si < 4; ++si) {
            int rs = sr[si] - 4; rs = rs < 0 ? 0 : (rs > 248 ? 248 : rs);
            act[si] = sv[si] && !sx[si] && kr >= rs && kr < rs + 8;
        }
#define NA_LOC(si_) do { int cs = snb[si_] * 16 - 8; cs = cs < 0 ? 0 : (cs > 32 ? 32 : cs); const int qc = snb[si_] * 16 + fr; \
            int wsn = qc - 8; wsn = wsn < 0 ? 0 : (wsn > 48 ? 48 : wsn); \
            na_step_lds<true>(st[si_], kb, cs, kb + 8192, 128, cs, rpb + (kr - sr[si_] + 7) * 31, cs, qc, wsn, fr, fq); } while (0)
        if (act[0]) NA_LOC(0);
        if (act[1]) NA_LOC(1);
        if (act[2]) NA_LOC(2);
        if (act[3]) NA_LOC(3);
#undef NA_LOC
    }
    asm volatile("s_waitcnt vmcnt(0)" ::: "memory");
#define NA_CTX(si_, c_) na_step_lds<false>(st[si_], lds + NA_CK, (c_) * 32, lds + NA_CV, 512, (c_) * 32, rpb, 0, 0, 0, fr, fq)
    if (sv[0] && sv[1]) { for (int c = 0; c < 8; ++c) { NA_CTX(0, c); NA_CTX(1, c); } }
    else { if (sv[0]) for (int c = 0; c < 8; ++c) NA_CTX(0, c); if (sv[1]) for (int c = 0; c < 8; ++c) NA_CTX(1, c); }
    if (sv[2] && sv[3]) { for (int c = 0; c < 8; ++c) { NA_CTX(2, c); NA_CTX(3, c); } }
    else { if (sv[2]) for (int c = 0; c < 8; ++c) NA_CTX(2, c); if (sv[3]) for (int c = 0; c < 8; ++c) NA_CTX(3, c); }
#undef NA_CTX
#pragma unroll
    for (int si = 0; si < 4; ++si) {
        if (sv[si]) {
            float lsum = st[si].l;
            lsum += __shfl_xor(lsum, 16);
            lsum += __shfl_xor(lsum, 32);
            const float il = 1.f / lsum;
            const int q0 = sx[si] ? LAT + idx * 16 : sr[si] * 64 + snb[si] * 16;
#pragma unroll
            for (int dt = 0; dt < 4; ++dt)
                *(uint2*)(Y + (size_t)brow(q0 + fr) * D + 256 + h * 64 + dt * 16 + fq * 4) =
                    pack4(st[si].o[dt][0] * il, st[si].o[dt][1] * il, st[si].o[dt][2] * il, st[si].o[dt][3] * il);
        }
    }
#undef NA_STAGE
#undef NA_GLDS
    __syncthreads();
}

__device__ void retu_item(const Params& p, int item) {
    const int lane = opaque_tid() & 63, fr = lane & 15, fq = lane >> 4;
    const int dir = item & 1, ch_h = item >> 1, h = ch_h % 6, chunk = ch_h / 6;
    const bf16_t* Vt = (const bf16_t*)(p.ws + OFF_RVT) + (size_t)(h * 64) * MT + chunk * 128;
    const bf16_t* Kt = (const bf16_t*)(p.ws + (dir ? OFF_RKB : OFF_RKF)) + (size_t)(h * 64) * MT + chunk * 128;
    float* U = (float*)(p.ws + OFF_US) + ((size_t)(chunk * 2 + dir) * 6 + h) * 4096;
    f32x4 acc[4][4];
#pragma unroll
    for (int i = 0; i < 4; ++i)
#pragma unroll
        for (int j = 0; j < 4; ++j) acc[i][j] = (f32x4){0.f, 0.f, 0.f, 0.f};
    bf16x8 vf[4][4], kf[4][4];
#pragma unroll
    for (int ks = 0; ks < 4; ++ks)
#pragma unroll
        for (int t = 0; t < 4; ++t) {
            vf[ks][t] = *(const bf16x8*)(Vt + (size_t)(t * 16 + fr) * MT + ks * 32 + fq * 8);
            kf[ks][t] = *(const bf16x8*)(Kt + (size_t)(t * 16 + fr) * MT + ks * 32 + fq * 8);
        }
    PIN8(vf[0][0], vf[0][1], vf[0][2], vf[0][3], kf[0][0], kf[0][1], kf[0][2], kf[0][3]);
    PIN8(vf[1][0], vf[1][1], vf[1][2], vf[1][3], kf[1][0], kf[1][1], kf[1][2], kf[1][3]);
    PIN8(vf[2][0], vf[2][1], vf[2][2], vf[2][3], kf[2][0], kf[2][1], kf[2][2], kf[2][3]);
    PIN8(vf[3][0], vf[3][1], vf[3][2], vf[3][3], kf[3][0], kf[3][1], kf[3][2], kf[3][3]);
#pragma unroll
    for (int ks = 0; ks < 4; ++ks)
#pragma unroll
        for (int et = 0; et < 4; ++et)
#pragma unroll
            for (int dt = 0; dt < 4; ++dt) acc[et][dt] = mfma16(vf[ks][et], kf[ks][dt], acc[et][dt]);
#pragma unroll
    for (int et = 0; et < 4; ++et)
#pragma unroll
        for (int dt = 0; dt < 4; ++dt)
#pragma unroll
            for (int j = 0; j < 4; ++j) __builtin_nontemporal_store(acc[et][dt][j], U + (et * 16 + fq * 4 + j) * 64 + dt * 16 + fr);
}

__device__ __forceinline__ void phase_scan(const Params& p, int l) {
    float* US = (float*)(p.ws + OFF_US);
    bf16_t* S16 = (bf16_t*)(p.ws + OFF_RKF);
    for (int e = blockIdx.x * NT + opaque_tid(); e < 2 * 6 * 4096; e += gridDim.x * NT) {
        const int dir = e / 24576, rem = e % 24576, h = rem >> 12, ed = rem & 4095;
        const float lg = dir ? p.dec_b[l * 6 + h] : p.dec_f[l * 6 + h];
        const float cd = __expf(128.f * lg);
        float s = 0.f;
        for (int b = 0; b < 5; ++b) {
            float u[26];
            size_t idx[26];
#pragma unroll
            for (int i = 0; i < 26; ++i) {
                const int q = b * 26 + i;
                int chunk;
                if (dir == 0) chunk = q < 2 ? 128 + q : q - 2;
                else chunk = q < 2 ? 129 - q : 129 - q;
                idx[i] = ((size_t)(chunk * 2 + dir) * 6 + h) * 4096 + ed;
                u[i] = __builtin_nontemporal_load(US + idx[i]);
            }
#pragma unroll
            for (int i = 0; i < 26; ++i) {
                S16[idx[i]] = (bf16_t)(pack_bf16(s, 0.f) & 0xffffu);
                s = s * cd + u[i];
            }
        }
    }
}

__device__ void reto_item(const Params& p, int l, int item) {
    const int lane = opaque_tid() & 63, fr = lane & 15, fq = lane >> 4;
    const int iq = item & 3, ch_h = item >> 2, h = ch_h % 6, chunk = ch_h / 6;
    const int tok0 = chunk * 128;
    const bf16_t* P = (const bf16_t*)(p.ws + OFF_P);
    const bf16_t* RVt = (const bf16_t*)(p.ws + OFF_RVT);
    const bf16_t* S16 = (const bf16_t*)(p.ws + OFF_RKF);
    bf16_t* Y = (bf16_t*)(p.ws + OFF_AY);
    const float lgf = p.dec_f[l * 6 + h] * 1.44269504f, lgb = p.dec_b[l * 6 + h] * 1.44269504f;
    bf16x8 qf[2][2], kf[4][2][2], vf[4][4];
#pragma unroll
    for (int it = 0; it < 2; ++it)
#pragma unroll
        for (int ks = 0; ks < 2; ++ks) qf[it][ks] = *(const bf16x8*)(P + (size_t)(tok0 + iq * 32 + it * 16 + fr) * IN_DIM + C_RQ + h * 64 + ks * 32 + fq * 8);
#pragma unroll
    for (int pp = 0; pp < 4; ++pp)
#pragma unroll
        for (int jj = 0; jj < 2; ++jj) {
            const bf16_t* kp = P + (size_t)(tok0 + pp * 32 + 8 * (fr >> 2) + 4 * jj + (fr & 3)) * IN_DIM + C_RK + h * 64 + fq * 8;
            kf[pp][jj][0] = *(const bf16x8*)kp; kf[pp][jj][1] = *(const bf16x8*)(kp + 32);
        }
#pragma unroll
    for (int pp = 0; pp < 2; ++pp)
#pragma unroll
        for (int et = 0; et < 4; ++et) vf[pp][et] = *(const bf16x8*)(RVt + (size_t)(h * 64 + et * 16 + fr) * MT + tok0 + pp * 32 + fq * 8);
    bf16x8 sf[2][4][2];
    PIN8(qf[0][0], qf[0][1], qf[1][0], qf[1][1], kf[0][0][0], kf[0][0][1], kf[0][1][0], kf[0][1][1]);
    PIN8(kf[1][0][0], kf[1][0][1], kf[1][1][0], kf[1][1][1], kf[2][0][0], kf[2][0][1], kf[2][1][0], kf[2][1][1]);
    PIN8(kf[3][0][0], kf[3][0][1], kf[3][1][0], kf[3][1][1], vf[0][0], vf[0][1], vf[0][2], vf[0][3]);
    asm volatile("" : "+v"(vf[1][0]), "+v"(vf[1][1]), "+v"(vf[1][2]), "+v"(vf[1][3]) :: "memory");
#pragma unroll
    for (int pp = 2; pp < 4; ++pp)
#pragma unroll
        for (int et = 0; et < 4; ++et) vf[pp][et] = *(const bf16x8*)(RVt + (size_t)(h * 64 + et * 16 + fr) * MT + tok0 + pp * 32 + fq * 8);
    uint2 gu[2][4];
    f32x4 gnv[4];
#pragma unroll
    for (int it = 0; it < 2; ++it)
#pragma unroll
        for (int et = 0; et < 4; ++et) gu[it][et] = *(const uint2*)(P + (size_t)(tok0 + iq * 32 + it * 16 + fr) * IN_DIM + C_GT + h * 64 + et * 16 + fq * 4);
#pragma unroll
    for (int et = 0; et < 4; ++et) gnv[et] = *(const f32x4*)(p.gn_g + (size_t)l * 384 + h * 64 + et * 16 + fq * 4);
    f32x4 y[4][2];
#pragma unroll
    for (int et = 0; et < 4; ++et)
#pragma unroll
        for (int it = 0; it < 2; ++it) y[et][it] = (f32x4){0.f, 0.f, 0.f, 0.f};
#pragma unroll
    for (int pp = 0; pp < 4; ++pp) {
        if (pp == 2) {
            PIN8(vf[2][0], vf[2][1], vf[2][2], vf[2][3], vf[3][0], vf[3][1], vf[3][2], vf[3][3]);
#pragma unroll
            for (int dir = 0; dir < 2; ++dir)
#pragma unroll
                for (int et = 0; et < 4; ++et)
#pragma unroll
                    for (int ks = 0; ks < 2; ++ks) sf[dir][et][ks] = *(const bf16x8*)(S16 + ((size_t)(chunk * 2 + dir) * 6 + h) * 4096 + (et * 16 + fr) * 64 + ks * 32 + fq * 8);
        }
        f32x4 a[2][2];
#pragma unroll
        for (int jj = 0; jj < 2; ++jj)
#pragma unroll
            for (int it = 0; it < 2; ++it) {
                a[jj][it] = mfma16(kf[pp][jj][0], qf[it][0], (f32x4){0.f, 0.f, 0.f, 0.f});
                a[jj][it] = mfma16(kf[pp][jj][1], qf[it][1], a[jj][it]);
            }
        bf16x8 bt[2];
#pragma unroll
        for (int it = 0; it < 2; ++it) {
            const int i = iq * 32 + it * 16 + fr;
            float pv[8];
#pragma unroll
            for (int jj = 0; jj < 2; ++jj)
#pragma unroll
                for (int rr = 0; rr < 4; ++rr) {
                    const int j = pp * 32 + fq * 8 + jj * 4 + rr;
                    const int df = i - j;
                    const float dcy = (df >= 0 ? __builtin_amdgcn_exp2f((float)df * lgf) : 0.f) + (df <= 0 ? __builtin_amdgcn_exp2f((float)(-df) * lgb) : 0.f);
                    pv[jj * 4 + rr] = a[jj][it][rr] * dcy;
                }
            const uint4 pu = make_uint4(pack_bf16(pv[0], pv[1]), pack_bf16(pv[2], pv[3]), pack_bf16(pv[4], pv[5]), pack_bf16(pv[6], pv[7]));
            bt[it] = *reinterpret_cast<const bf16x8*>(&pu);
        }
#pragma unroll
        for (int et = 0; et < 4; ++et)
#pragma unroll
            for (int it = 0; it < 2; ++it) y[et][it] = mfma16(vf[pp][et], bt[it], y[et][it]);
    }
    PIN8(sf[0][0][0], sf[0][0][1], sf[0][1][0], sf[0][1][1], sf[0][2][0], sf[0][2][1], sf[0][3][0], sf[0][3][1]);
    PIN8(sf[1][0][0], sf[1][0][1], sf[1][1][0], sf[1][1][1], sf[1][2][0], sf[1][2][1], sf[1][3][0], sf[1][3][1]);
    PIN8(gu[0][0], gu[0][1], gu[0][2], gu[0][3], gu[1][0], gu[1][1], gu[1][2], gu[1][3]);
    asm volatile("" : "+v"(gnv[0]), "+v"(gnv[1]), "+v"(gnv[2]), "+v"(gnv[3]) :: "memory");
#pragma unroll
    for (int dir = 0; dir < 2; ++dir) {
        f32x4 z[4][2];
#pragma unroll
        for (int et = 0; et < 4; ++et) {
            z[et][0] = (f32x4){0.f, 0.f, 0.f, 0.f};
            z[et][1] = (f32x4){0.f, 0.f, 0.f, 0.f};
#pragma unroll
            for (int ks = 0; ks < 2; ++ks) {
                z[et][0] = mfma16(sf[dir][et][ks], qf[0][ks], z[et][0]);
                z[et][1] = mfma16(sf[dir][et][ks], qf[1][ks], z[et][1]);
            }
        }
#pragma unroll
        for (int it = 0; it < 2; ++it) {
            const int ii = iq * 32 + it * 16 + fr;
            const float sc = dir == 0 ? __builtin_amdgcn_exp2f((float)(ii + 1) * lgf) : __builtin_amdgcn_exp2f((float)(128 - ii) * lgb);
#pragma unroll
            for (int et = 0; et < 4; ++et) y[et][it] += z[et][it] * sc;
        }
    }
#pragma unroll
    for (int it = 0; it < 2; ++it) {
        float s = 0.f;
#pragma unroll
        for (int et = 0; et < 4; ++et) s += y[et][it][0] + y[et][it][1] + y[et][it][2] + y[et][it][3];
        s += __shfl_xor(s, 16);
        s += __shfl_xor(s, 32);
        const float mu = s * (1.f / 64.f);
        float v = 0.f;
#pragma unroll
        for (int et = 0; et < 4; ++et)
#pragma unroll
            for (int j = 0; j < 4; ++j) { const float d = y[et][it][j] - mu; v += d * d; }
        v += __shfl_xor(v, 16);
        v += __shfl_xor(v, 32);
        const float rs = rsqrtf(v * (1.f / 64.f) + 1e-6f);
        const int tok = tok0 + iq * 32 + it * 16 + fr;
#pragma unroll
        for (int et = 0; et < 4; ++et) {
            const int e0 = et * 16 + fq * 4;
            const f32x4 gn = gnv[et];
            const float g0 = bf2f(gu[it][et].x & 0xffffu), g1 = bf2f(gu[it][et].x >> 16), g2 = bf2f(gu[it][et].y & 0xffffu), g3 = bf2f(gu[it][et].y >> 16);
            *(uint2*)(Y + (size_t)brow(tok) * D + 640 + h * 64 + e0) =
                pack4((y[et][it][0] - mu) * rs * gn[0] * g0, (y[et][it][1] - mu) * rs * gn[1] * g1, (y[et][it][2] - mu) * rs * gn[2] * g2,
                      (y[et][it][3] - mu) * rs * gn[3] * g3);
        }
    }
}

__device__ __forceinline__ void phase_mix1(const Params& p, int l, float* lds) {
    const int tid = opaque_tid(), wave = tid >> 6, half = tid >> 8;
    const bool with_ctx = l < DEPTH - 1;
    const int npool = (with_ctx ? MT : LAT) / 64 * 4;
    for (int rep = 0; rep < (PROBE_DUP == 12 ? 2 : 1); ++rep)
    for (int it0 = blockIdx.x * 2; it0 < npool; it0 += gridDim.x * 2) pool_item(p, l, it0 + half, (unsigned char*)lds + half * 40960, tid & 255);
    for (int rep = 0; rep < (PROBE_DUP == 11 ? 2 : 1); ++rep) phase_na(p, l, with_ctx, (unsigned char*)lds);
    const int gw = blockIdx.x * 8 + wave, nw = gridDim.x * 8;
    for (int rep = 0; rep < (PROBE_DUP == 13 ? 2 : 1); ++rep)
    for (int it = gw; it < NCHUNK * 6 * 2; it += nw) retu_item(p, it);
    __syncthreads();
}
__device__ __forceinline__ void phase_mix3(const Params& p, int l) {
    const int wave = opaque_tid() >> 6;
    const bool with_ctx = l < DEPTH - 1;
    const int n = (with_ctx ? NCHUNK : 128) * 6 * 4;
    for (int it = blockIdx.x * 8 + wave; it < n; it += gridDim.x * 8) reto_item(p, l, it);
}

__device__ void run_phase(const Params& p, int ph, unsigned char* lds) {
    if (ph == 0) { phase_prep(p, (float*)lds); return; }
    if (ph == NPHASE - 1) { phase_final(p); return; }
    const int l = (ph - 1) / 9, s = (ph - 1) % 9;
    const bool with_ctx = l < DEPTH - 1;
    const bf16_t* wl = (const bf16_t*)(p.ws + OFF_WT) + (size_t)l * WT_LAYER;
    switch (s) {
        case 1: phase_inproj(p, l, lds); break;
        case 2: phase_mix1(p, l, (float*)lds); break;
        case 3: phase_scan(p, l); break;
        case 4: phase_mix3(p, l); break;
        case 0:
        case 6: {
            const bool second = s == 6;
            phase_norm(p, l, (second ? p.norm2_g : p.norm1_g) + (size_t)l * D, second ? 3 : 0, (second && !with_ctx) ? LAT : MT, second ? 4 : (l > 0 ? 11 : 0));
            break;
        }
        case 7: phase_up(p, l, with_ctx, lds); break;
        case 5:
        case 8: {
            const bool down = s == 8;
            phase_resid(p, l, !down, (const bf16_t*)(p.ws + (down ? OFF_P : OFF_AY)), wl + (down ? WT_DOWN : WT_OUT), down ? DFF : D, down ? 5 : 2, with_ctx ? 65 : 64, lds);
            break;
        }
    }
}

__global__ void __launch_bounds__(512, 2) fwd_kernel(Params p) {
    extern __shared__ __attribute__((aligned(16))) unsigned char lds[];
    uint4& xb_words = *(uint4*)(lds + XB_OFF);
#if ONE_LAUNCH
    cg::grid_group grid = cg::this_grid();
    if (threadIdx.x == 0) xb_words = make_uint4(0u, 0u, 0u, 0u);
    __syncthreads();
    XcdBarrier xb = xcd_barrier_post((unsigned*)(p.ws + OFF_BAR), (volatile LAS unsigned*)&xb_words);
#endif
    int ph = p.ph_lo, rep = 0;
    while (ph < p.ph_hi) {
        run_phase(p, ph, lds);
        bool again = false;
#if PROBE_DUP >= 0 && PROBE_DUP < 10
        again = rep == 0 && ((PROBE_DUP == 9 && ph == 0) || (PROBE_DUP < 9 && ph > 0 && ph < NPHASE - 1 && (ph - 1) % 9 == PROBE_DUP));
#endif
        rep = again ? 1 : 0;
        if (!again) ++ph;
#if ONE_LAUNCH
        if (ph < p.ph_hi) {
            if (p.ph_hi > NPHASE) grid.sync();
            xcd_barrier(xb);
        }
#endif
    }
}

extern "C" void kernel_launch(void* const* d_in, const int* in_sizes, int n_in, void* d_out, int out_size, void* d_ws, size_t ws_size,
                              hipStream_t stream) {
    static int grid_blocks = 0;
    if (!grid_blocks) {
        int dev = 0, cus = 0, per_cu = 0;
        hipGetDevice(&dev);
        hipDeviceGetAttribute(&cus, hipDeviceAttributeMultiprocessorCount, dev);
        hipFuncSetAttribute((const void*)fwd_kernel, hipFuncAttributeMaxDynamicSharedMemorySize, LDS_BYTES);
        hipOccupancyMaxActiveBlocksPerMultiprocessor(&per_cu, (const void*)fwd_kernel, NT, LDS_BYTES);
        if (per_cu < 1) per_cu = 1;
        if (per_cu > 1) per_cu = 1;
        grid_blocks = cus * per_cu;
        if (ws_size < WS_END) fprintf(stderr, "kernel_launch: workspace too small: %zu < %zu\n", ws_size, (size_t)WS_END);
    }
    Params p{};
    const float** pf = (const float**)&p;
    for (int i = 0; i < 21; ++i) pf[i] = (const float*)d_in[i];
    p.out = (float*)d_out;
    p.ws = (unsigned char*)d_ws;
#if ONE_LAUNCH
    hipMemsetAsync((unsigned char*)d_ws + OFF_BAR, 0, 16384, stream);
    p.ph_lo = 0;
    p.ph_hi = NPHASE;
    void* args[] = {&p};
    hipError_t e = hipLaunchCooperativeKernel((const void*)fwd_kernel, dim3(grid_blocks), dim3(NT), args, LDS_BYTES, stream);
    if (e != hipSuccess) fprintf(stderr, "cooperative launch failed: %s (grid %d)\n", hipGetErrorString(e), grid_blocks);
#else
    for (int ph = 0; ph < NPHASE; ++ph) {
        p.ph_lo = ph;
        p.ph_hi = ph + 1;
        hipLaunchKernelGGL(fwd_kernel, dim3(grid_blocks), dim3(NT), LDS_BYTES, stream, p);
    }
#endif
}
```

```cpp
#include <hip/hip_runtime.h>
#include <hip/hip_cooperative_groups.h>
#include <cstdio>
#include <cstdint>
namespace cg = cooperative_groups;

#ifndef ONE_LAUNCH
#define ONE_LAUNCH 1
#endif
#ifndef PROBE_DUP
#define PROBE_DUP -1
#endif

typedef unsigned short bf16_t;
typedef short bf16x8 __attribute__((ext_vector_type(8)));
typedef float f32x4 __attribute__((ext_vector_type(4)));

constexpr int D = 1024, LAT = 16384, NCTX = 256, MT = LAT + NCTX, DEPTH = 4;
constexpr int IN_DIM = 2944, DFF = 2816, NUP = 2 * DFF;
constexpr int NCHUNK = MT / 128;
constexpr int C_POOL = 0, C_NQ = 256, C_NK = 640, C_NV = 1024, C_RQ = 1408, C_RK = 1792, C_RV = 2176, C_GT = 2560;

constexpr int IN_PAD = 3072, AY_ROWS = 16896, CTXB = 16386;
constexpr size_t WT_IN = 0, WT_OUT = (size_t)IN_PAD * D, WT_UP = WT_OUT + (size_t)D * D, WT_DOWN = WT_UP + (size_t)NUP * D;
constexpr size_t WT_LAYER = WT_DOWN + (size_t)D * DFF;
constexpr size_t OFF_BAR = 0;
constexpr size_t OFF_WT = 16384;
constexpr size_t OFF_H = OFF_WT + WT_LAYER * 2 * DEPTH;
constexpr size_t OFF_AY = OFF_H + (size_t)MT * D * 4;
constexpr size_t OFF_P = OFF_AY + (size_t)AY_ROWS * D * 2;
constexpr size_t OFF_NVT = OFF_P + (size_t)MT * IN_DIM * 2;
constexpr size_t OFF_RVT = OFF_NVT + (size_t)384 * MT * 2;
constexpr size_t OFF_RKF = OFF_RVT + (size_t)384 * MT * 2;
constexpr size_t OFF_RKB = OFF_RKF + (size_t)384 * MT * 2;
constexpr size_t OFF_US = OFF_RKB + (size_t)384 * MT * 2;
constexpr size_t OFF_MOD = OFF_US + (size_t)NCHUNK * 2 * 6 * 4096 * 4;
constexpr size_t OFF_ROPE = OFF_MOD + (size_t)DEPTH * 2 * 6 * D * 4;
constexpr size_t OFF_PART = OFF_ROPE + (size_t)256 * 16 * 2 * 4;
constexpr size_t WS_END = OFF_PART + (size_t)11 * 256 * 1024 * 4;

constexpr int NT = 512;
constexpr int GEMM_LDS = 131072;
constexpr int XB_OFF = 135168;
constexpr int CW_OFF = 136192;
constexpr int LDS_BYTES = CW_OFF + 8192;
constexpr int NPHASE = 2 + 9 * DEPTH;

struct Params {
    const float *x, *c, *ctx, *c_ctx, *w_mod, *b_mod, *norm1_g, *w_in, *pool_w, *pool_scale, *na_rpb, *dec_f, *dec_b, *gn_g,
        *w_out, *norm2_g, *w_up, *conv_w, *conv_b, *w_down, *final_g;
    float* out;
    unsigned char* ws;
    int ph_lo, ph_hi;
};

__device__ __forceinline__ float bf2f(unsigned b) { return __uint_as_float(b << 16); }
__device__ __forceinline__ unsigned pack_bf16(float lo, float hi) {
    unsigned r;
    asm("v_cvt_pk_bf16_f32 %0, %1, %2" : "=v"(r) : "v"(lo), "v"(hi));
    return r;
}
__device__ __forceinline__ uint2 pack4(float a, float b, float c, float d) { return make_uint2(pack_bf16(a, b), pack_bf16(c, d)); }
__device__ __forceinline__ f32x4 mfma16(bf16x8 a, bf16x8 b, f32x4 c) { return __builtin_amdgcn_mfma_f32_16x16x32_bf16(a, b, c, 0, 0, 0); }
__device__ __forceinline__ bf16x8 mk8(uint2 lo, uint2 hi) {
    uint4 u = make_uint4(lo.x, lo.y, hi.x, hi.y);
    return *reinterpret_cast<bf16x8*>(&u);
}
__device__ __forceinline__ float silu_f(float v) { return v * __builtin_amdgcn_rcpf(1.f + __expf(-v)); }
__device__ __forceinline__ int brow(int t) { return t < LAT ? t + 1 : t + 3; }

#define PIN8(a, b, c, d, e, f, g, h) asm volatile("" : "+v"(a), "+v"(b), "+v"(c), "+v"(d), "+v"(e), "+v"(f), "+v"(g), "+v"(h) :: "memory")
__device__ __forceinline__ int opaque_tid() {
    int t = threadIdx.x;
    asm volatile("" : "+v"(t));
    return t;
}

#define XB_TMO 128
#define XB_XCNT(j) (256 + 64 * (j))
#define XB_XSUB(j) (1280 + 64 * (j))
#define XB_XGEN(j) (2304 + 64 * (j))
#define XB_TOP 3328
#define XB_TOPGEN 3392
#define XCD_BAR_WORDS 3456
#define XB_SPIN_CAP (1u << 22)
#define LAS __attribute__((address_space(3)))
__device__ __forceinline__ unsigned xb_ld(unsigned* p) { return __hip_atomic_load(p, __ATOMIC_RELAXED, __HIP_MEMORY_SCOPE_AGENT); }
__device__ __forceinline__ unsigned xb_add(unsigned* p, unsigned v) { return __hip_atomic_fetch_add(p, v, __ATOMIC_RELAXED, __HIP_MEMORY_SCOPE_AGENT); }
__device__ __forceinline__ unsigned xb_xcc_id() { return (unsigned)__builtin_amdgcn_s_getreg((3 << 11) | 20) & 0xFu; }
#define XB_SPIN(cond, bar)                                                                 \
    do {                                                                                   \
        unsigned _sp = 0;                                                                  \
        while (cond) {                                                                     \
            __builtin_amdgcn_s_sleep(1);                                                   \
            if ((++_sp & 255u) == 0u) {                                                    \
                if (xb_ld(&(bar)[XB_TMO])) break;                                          \
                if (_sp > XB_SPIN_CAP) { atomicAdd(&(bar)[XB_TMO], 1u); break; }           \
            }                                                                              \
        }                                                                                  \
    } while (0)
struct XcdBarrier { unsigned* bar; unsigned x; volatile LAS unsigned* st; };
__device__ __forceinline__ XcdBarrier xcd_barrier_post(unsigned* bar, volatile LAS unsigned* st) {
    XcdBarrier b; b.bar = bar; b.x = xb_xcc_id(); b.st = st;
    if (threadIdx.x == 0) (void)xb_add(&bar[XB_XCNT(b.x)], 1u);
    return b;
}
__device__ __forceinline__ void xcd_barrier_complete(unsigned* bar, unsigned x, unsigned& nloc, unsigned& nx) {
    const unsigned G = gridDim.x * gridDim.y * gridDim.z;
    unsigned sum, cnt, mine, sp = 0u;
    for (;;) {
        sum = 0u; cnt = 0u; mine = 0u;
#pragma unroll
        for (unsigned j = 0; j < 16; ++j) { const unsigned c = xb_ld(&bar[XB_XCNT(j)]); sum += c; cnt += (c > 0u) ? 1u : 0u; mine = (j == x) ? c : mine; }
        if (sum == G) break;
        __builtin_amdgcn_s_sleep(1);
        if ((++sp & 255u) == 0u) { if (xb_ld(&bar[XB_TMO])) break; if (sp > XB_SPIN_CAP) { atomicAdd(&bar[XB_TMO], 1u); break; } }
    }
    nloc = mine > 0u ? mine : 1u; nx = cnt > 0u ? cnt : 1u;
}
__device__ __forceinline__ void xcd_barrier(const XcdBarrier& b) {
    asm volatile("s_waitcnt vmcnt(0)" ::: "memory");
    __syncthreads();
    if (threadIdx.x == 0) {
        unsigned* bar = b.bar;
        __builtin_amdgcn_s_waitcnt(0);
        unsigned nloc = b.st[0], nx = b.st[1];
        if (nloc == 0u) { xcd_barrier_complete(bar, b.x, nloc, nx); b.st[0] = nloc; b.st[1] = nx; }
        const unsigned old = xb_add(&bar[XB_XSUB(b.x)], 1u);
        const unsigned gen = old / nloc;
        if (old + 1u == (gen + 1u) * nloc) {
            __builtin_amdgcn_fence(__ATOMIC_RELEASE, "agent");
            asm volatile("s_waitcnt vmcnt(0)" ::: "memory");
            const unsigned og = xb_add(&bar[XB_TOP], 1u);
            const unsigned tg = og / nx;
            if (og + 1u == (tg + 1u) * nx) xb_add(&bar[XB_TOPGEN], 1u);
            else XB_SPIN(xb_ld(&bar[XB_TOPGEN]) == tg, bar);
            __builtin_amdgcn_fence(__ATOMIC_ACQUIRE, "agent");
            xb_add(&bar[XB_XGEN(b.x)], 1u);
            asm volatile("s_waitcnt vmcnt(0)" ::: "memory");
        } else {
            XB_SPIN(xb_ld(&bar[XB_XGEN(b.x)]) == gen, bar);
            __builtin_amdgcn_fence(__ATOMIC_ACQUIRE, "agent");
            asm volatile("s_waitcnt vmcnt(0)" ::: "memory");
        }
    }
    __syncthreads();
}

__device__ void conv_weight_tile(const float* __restrict__ src, int N, bf16_t* __restrict__ dst, int K, int k0, int n0, int dst_row0, bool up_perm, float* lds, int tid) {
    f32x4 v[4];
#pragma unroll
    for (int i = 0; i < 4; ++i) v[i] = __builtin_nontemporal_load((const f32x4*)(src + (size_t)(k0 + (tid >> 4) + 16 * i) * N + n0 + (tid & 15) * 4));
    asm volatile("" : "+v"(v[0]), "+v"(v[1]), "+v"(v[2]), "+v"(v[3]) :: "memory");
#pragma unroll
    for (int i = 0; i < 4; ++i) {
        float* p = lds + ((tid >> 4) + 16 * i) * 65 + (tid & 15) * 4;
        p[0] = v[i][0]; p[1] = v[i][1]; p[2] = v[i][2]; p[3] = v[i][3];
    }
    __syncthreads();
    const int nn = tid >> 2, ks = (tid & 3) * 16;
    unsigned w[8];
#pragma unroll
    for (int j = 0; j < 8; ++j) w[j] = pack_bf16(lds[(ks + 2 * j) * 65 + nn], lds[(ks + 2 * j + 1) * 65 + nn]);
    int drow = dst_row0 + nn;
    if (up_perm) {
        const int half = n0 >= DFF ? 1 : 0, ff = n0 - half * DFF + nn;
        drow = 32 * (ff >> 4) + 16 * half + (ff & 15);
    }
    uint4* d = (uint4*)(dst + (size_t)drow * K + k0 + ks);
    d[0] = make_uint4(w[0], w[1], w[2], w[3]);
    d[1] = make_uint4(w[4], w[5], w[6], w[7]);
    __syncthreads();
}

constexpr int CONV_PER_LAYER = 736 + 256 + 1408 + 704;
__device__ __forceinline__ void conv_layer_item(const Params& p, int l, int r, float* lds, int tid) {
    bf16_t* wl = (bf16_t*)(p.ws + OFF_WT) + (size_t)l * WT_LAYER;
    if (r < 736) {
        const int kt = r / 46, nt = r % 46;
        conv_weight_tile(p.w_in + (size_t)l * D * IN_DIM, IN_DIM, wl + WT_IN, D, kt * 64, nt * 64, nt * 64, false, lds, tid);
    } else if (r < 736 + 256) {
        r -= 736;
        const int kt = r / 16, nt = r % 16;
        conv_weight_tile(p.w_out + (size_t)l * D * D, D, wl + WT_OUT, D, kt * 64, nt * 64, nt * 64, false, lds, tid);
    } else if (r < 736 + 256 + 1408) {
        r -= 736 + 256;
        const int kt = r / 88, nt = r % 88;
        conv_weight_tile(p.w_up + (size_t)l * D * NUP, NUP, wl + WT_UP, D, kt * 64, nt * 64, 0, true, lds, tid);
    } else {
        r -= 736 + 256 + 1408;
        const int kt = r / 16, nt = r % 16;
        conv_weight_tile(p.w_down + (size_t)l * DFF * D, D, wl + WT_DOWN, DFF, kt * 64, nt * 64, nt * 64, false, lds, tid);
    }
}

__device__ __forceinline__ void phase_prep(const Params& p, float* lds_all) {
    const int tid_all = opaque_tid(), half = tid_all >> 8, tid = tid_all & 255;
    float* lds = lds_all + half * 8192;
    constexpr int REST = CONV_PER_LAYER - 1408;
    constexpr int NW = CONV_PER_LAYER + (DEPTH - 1) * REST;
    constexpr int NMOD = DEPTH * 96;
    for (int it0 = blockIdx.x * 2; it0 < NW + NMOD; it0 += gridDim.x * 2) {
        const int it = it0 + half;
        if (it < NW) {
            if (it < CONV_PER_LAYER) conv_layer_item(p, 0, it, lds, tid);
            else {
                const int e = it - CONV_PER_LAYER, l = 1 + e / REST, r = e % REST;
                conv_layer_item(p, l, r < 992 ? r : r + 1408, lds, tid);
            }
        } else {
            const int mi = it - NW, l = mi / 96, col0 = (mi % 96) * 64;
            float* sx = lds;
            float* sc = lds + 1024;
            float* red = lds + 2048;
            for (int k = tid; k < 1024; k += 256) { sx[k] = silu_f(p.c[k]); sc[k] = silu_f(p.c_ctx[k]); }
            __syncthreads();
            const int kq = tid >> 4, cq = tid & 15;
            float ax[4] = {0.f, 0.f, 0.f, 0.f}, ac[4] = {0.f, 0.f, 0.f, 0.f};
            const float* wp = p.w_mod + ((size_t)l * 1024 + kq * 64) * 6144 + col0 + cq * 4;
            for (int k0 = 0; k0 < 64; k0 += 16) {
                f32x4 w4[16];
#pragma unroll
                for (int k = 0; k < 16; ++k) w4[k] = __builtin_nontemporal_load((const f32x4*)(wp + (size_t)(k0 + k) * 6144));
                PIN8(w4[0], w4[1], w4[2], w4[3], w4[4], w4[5], w4[6], w4[7]);
                PIN8(w4[8], w4[9], w4[10], w4[11], w4[12], w4[13], w4[14], w4[15]);
#pragma unroll
                for (int k = 0; k < 16; ++k) {
                    const float a = sx[kq * 64 + k0 + k], b = sc[kq * 64 + k0 + k];
                    ax[0] += a * w4[k][0]; ax[1] += a * w4[k][1]; ax[2] += a * w4[k][2]; ax[3] += a * w4[k][3];
                    ac[0] += b * w4[k][0]; ac[1] += b * w4[k][1]; ac[2] += b * w4[k][2]; ac[3] += b * w4[k][3];
                }
            }
#pragma unroll
            for (int j = 0; j < 4; ++j) { red[(kq * 64 + cq * 4 + j) * 2] = ax[j]; red[(kq * 64 + cq * 4 + j) * 2 + 1] = ac[j]; }
            __syncthreads();
            if (tid < 128) {
                const int col = tid >> 1, which = tid & 1;
                float s = 0.f;
#pragma unroll
                for (int q = 0; q < 16; ++q) s += red[(q * 64 + col) * 2 + which];
                float* mod = (float*)(p.ws + OFF_MOD);
                mod[((size_t)l * 2 + which) * 6144 + col0 + col] = s + p.b_mod[(size_t)l * 6144 + col0 + col];
            }
            __syncthreads();
        }
    }
    float* rope = (float*)(p.ws + OFF_ROPE);
    for (int i = blockIdx.x * NT + tid_all; i < 4096; i += gridDim.x * NT) {
        const int pos = i >> 4, d = i & 15;
        const float inv = powf(10000.f, -(float)d / 16.f);
        const float ang = (float)pos * inv;
        rope[i] = cosf(ang);
        rope[4096 + i] = sinf(ang);
    }
    {
        uint4* ay = (uint4*)(p.ws + OFF_AY);
        const int i = blockIdx.x * NT + tid_all;
        if (i < 512) {
            const int which = i >> 7, rr = which == 0 ? 0 : (which == 1 ? LAT + 1 : (which == 2 ? CTXB : CTXB + 257));
            ay[(size_t)rr * 128 + (i & 127)] = make_uint4(0u, 0u, 0u, 0u);
        }
    }
}

__device__ __forceinline__ void phase_norm(const Params& p, int l, const float* g, int shift_idx, int nrows, int npart) {
    const int tid = opaque_tid(), lane = tid & 63, wave = tid >> 6;
    const int gw = blockIdx.x * 8 + wave, nw = gridDim.x * 8;
    float* h = (float*)(p.ws + OFF_H);
    bf16_t* out = (bf16_t*)(p.ws + OFF_AY);
    const float* mod = (const float*)(p.ws + OFF_MOD) + (size_t)l * 2 * 6144 + shift_idx * D;
    {
        const float* src = (l == 0 && shift_idx == 0) ? p.x : h;
        f32x4 mul[4], add[4];
#pragma unroll
        for (int i = 0; i < 4; ++i) {
            const int col = i * 256 + lane * 4;
            mul[i] = *(const f32x4*)(g + col) * (*(const f32x4*)(mod + D + col) + 1.f);
            add[i] = *(const f32x4*)(mod + col);
        }
        for (int row0 = gw; row0 < LAT; row0 += 4 * nw) {
            f32x4 v[4][4];
#pragma unroll
            for (int k = 0; k < 4; ++k) {
                const int row = row0 + k * nw < LAT ? row0 + k * nw : row0;
#pragma unroll
                for (int i = 0; i < 4; ++i) v[k][i] = *(const f32x4*)(src + (size_t)row * D + i * 256 + lane * 4);
            }
            PIN8(v[0][0], v[0][1], v[0][2], v[0][3], v[1][0], v[1][1], v[1][2], v[1][3]);
            PIN8(v[2][0], v[2][1], v[2][2], v[2][3], v[3][0], v[3][1], v[3][2], v[3][3]);
#pragma unroll
            for (int k = 0; k < 4; ++k) {
                const int row = row0 + k * nw;
                if (row < LAT) {
                    float ss = 0.f;
#pragma unroll
                    for (int i = 0; i < 4; ++i) ss += v[k][i][0] * v[k][i][0] + v[k][i][1] * v[k][i][1] + v[k][i][2] * v[k][i][2] + v[k][i][3] * v[k][i][3];
#pragma unroll
                    for (int o = 32; o >= 1; o >>= 1) ss += __shfl_xor(ss, o);
                    const float r = rsqrtf(ss * (1.f / D) + 1e-6f);
#pragma unroll
                    for (int i = 0; i < 4; ++i) {
                        const f32x4 o = v[k][i] * r * mul[i] + add[i];
                        { const uint2 pk = pack4(o[0], o[1], o[2], o[3]); typedef unsigned u32x2 __attribute__((ext_vector_type(2))); u32x2 pv; pv[0] = pk.x; pv[1] = pk.y;
                          __builtin_nontemporal_store(pv, (u32x2*)(out + (size_t)(row + 1) * D + i * 256 + lane * 4)); }
                    }
                }
            }
        }
    }
    for (int row = LAT + gw; row < nrows; row += nw) {
        const float* hr = l == 0 ? p.ctx + (size_t)(row - LAT) * D : h + (size_t)row * D;
        const float* md = mod + 6144;
        f32x4 v[4];
#pragma unroll
        for (int i = 0; i < 4; ++i) v[i] = *(const f32x4*)(hr + i * 256 + lane * 4);
        if (npart > 0) {
            const float* pr = (const float*)(p.ws + OFF_PART) + (size_t)(row - LAT) * D;
            for (int s0 = 0; s0 < npart; s0 += 4) {
                f32x4 a[4][4];
#pragma unroll
                for (int s = 0; s < 4; ++s)
#pragma unroll
                    for (int i = 0; i < 4; ++i) a[s][i] = *(const f32x4*)(pr + (size_t)(s0 + s < npart ? s0 + s : npart - 1) * 256 * D + i * 256 + lane * 4);
                PIN8(a[0][0], a[0][1], a[0][2], a[0][3], a[1][0], a[1][1], a[1][2], a[1][3]);
                PIN8(a[2][0], a[2][1], a[2][2], a[2][3], a[3][0], a[3][1], a[3][2], a[3][3]);
#pragma unroll
                for (int s = 0; s < 4; ++s)
                    if (s0 + s < npart) {
#pragma unroll
                        for (int i = 0; i < 4; ++i) v[i] += a[s][i];
                    }
            }
#pragma unroll
            for (int i = 0; i < 4; ++i) *(f32x4*)(h + (size_t)row * D + i * 256 + lane * 4) = v[i];
        }
        float ss = 0.f;
#pragma unroll
        for (int i = 0; i < 4; ++i) ss += v[i][0] * v[i][0] + v[i][1] * v[i][1] + v[i][2] * v[i][2] + v[i][3] * v[i][3];
#pragma unroll
        for (int o = 32; o >= 1; o >>= 1) ss += __shfl_xor(ss, o);
        const float r = rsqrtf(ss * (1.f / D) + 1e-6f);
#pragma unroll
        for (int i = 0; i < 4; ++i) {
            const int col = i * 256 + lane * 4;
            const f32x4 o = v[i] * r * *(const f32x4*)(g + col) * (*(const f32x4*)(md + D + col) + 1.f) + *(const f32x4*)(md + col);
            *(uint2*)(out + (size_t)brow(row) * D + col) = pack4(o[0], o[1], o[2], o[3]);
        }
    }
}

__device__ __forceinline__ void phase_final(const Params& p) {
    const int tid = opaque_tid(), lane = tid & 63, wave = tid >> 6;
    const int gw = blockIdx.x * 8 + wave, nw = gridDim.x * 8;
    const float* h = (const float*)(p.ws + OFF_H);
    f32x4 gg[4];
#pragma unroll
    for (int i = 0; i < 4; ++i) gg[i] = *(const f32x4*)(p.final_g + i * 256 + lane * 4);
    for (int row0 = gw; row0 < LAT; row0 += 4 * nw) {
        f32x4 v[4][4];
#pragma unroll
        for (int k = 0; k < 4; ++k) {
            const int row = row0 + k * nw < LAT ? row0 + k * nw : row0;
#pragma unroll
            for (int i = 0; i < 4; ++i) v[k][i] = __builtin_nontemporal_load((const f32x4*)(h + (size_t)row * D + i * 256 + lane * 4));
        }
        PIN8(v[0][0], v[0][1], v[0][2], v[0][3], v[1][0], v[1][1], v[1][2], v[1][3]);
        PIN8(v[2][0], v[2][1], v[2][2], v[2][3], v[3][0], v[3][1], v[3][2], v[3][3]);
#pragma unroll
        for (int k = 0; k < 4; ++k) {
            const int row = row0 + k * nw;
            if (row < LAT) {
                float ss = 0.f;
#pragma unroll
                for (int i = 0; i < 4; ++i) ss += v[k][i][0] * v[k][i][0] + v[k][i][1] * v[k][i][1] + v[k][i][2] * v[k][i][2] + v[k][i][3] * v[k][i][3];
#pragma unroll
                for (int o = 32; o >= 1; o >>= 1) ss += __shfl_xor(ss, o);
                const float r = rsqrtf(ss * (1.f / D) + 1e-6f);
#pragma unroll
                for (int i = 0; i < 4; ++i) __builtin_nontemporal_store(v[k][i] * r * gg[i], (f32x4*)(p.out + (size_t)row * D + i * 256 + lane * 4));
            }
        }
    }
}

constexpr int BK = 64, HALF = 128, HTB = HALF * BK * 2, NXCD = 8, WGM = 8;
__device__ __forceinline__ int lds_byte(int r, int c) { const int st = (r >> 4) * 2 + (c >> 5), rr = r & 15, cc = c & 31, ob = rr * 64 + cc * 2; return st * 1024 + (ob ^ (((ob >> 9) & 1) << 5)); }
__device__ __forceinline__ void stage_rc(int b, int& R, int& C) { const int st = b / 1024, sb = b % 1024, swz = sb ^ (((sb >> 9) & 1) << 5); R = (st >> 1) * 16 + swz / 64; C = (st & 1) * 32 + (swz % 64) / 2; }
struct Unit { int pm, pn, k0, nt; };
struct StaticOrder {
    int nM, nN, nwg, G, c, ntf;
    int nx, xpm, xnt;
    __device__ void init(int nM_, int nN_, int K, int G_, int c_) { nM = nM_; nN = nN_; nwg = nM * nN; G = G_; c = c_; ntf = K / 64; nx = 0; xpm = 0; xnt = 4; }
    __device__ void split_extra(int pm, int xnt_) { xpm = pm; xnt = xnt_; nx = nN * (ntf / xnt_); }
    __device__ bool next(int i, Unit& u) const {
        const long L = (long)i * G + c; if (L >= nwg + nx) return false;
        if (L >= nwg) { const int e = (int)L - nwg; u.pm = xpm; u.pn = e % nN; u.k0 = (e / nN) * xnt * 64; u.nt = xnt; return true; }
        int wgid = (int)L; { const int q = nwg / NXCD, r = nwg % NXCD, xcd = wgid % NXCD, off = wgid / NXCD; wgid = (xcd < r ? xcd * (q + 1) : r * (q + 1) + (xcd - r) * q) + off; }
        const int nig = WGM * nN, gid = wgid / nig, fm = gid * WGM, gsz = (nM - fm) < WGM ? (nM - fm) : WGM;
        u.pm = fm + ((wgid % nig) % gsz); u.pn = (wgid % nig) / gsz; u.k0 = 0; u.nt = ntf; return true;
    }
};

template <class Epi>
__device__ __forceinline__ void gemm8(LAS unsigned char* lds, const bf16_t* A, int segstride, const bf16_t* Bt, int K, const StaticOrder& S, const Epi& E) {
    const int tid = opaque_tid(), wid = __builtin_amdgcn_readfirstlane(tid >> 6), lane = tid & 63, wr = wid >> 2, wc = wid & 3, fr = lane & 15, fq = lane >> 4;
    unsigned voffA[2], voffB[2];
#pragma unroll
    for (int i = 0; i < 2; ++i) { int R, C; stage_rc(tid * 16 + i * 8192, R, C);
        voffA[i] = (unsigned)(((R >> 6) * segstride + (R & 63)) * K + C) * 2u; voffB[i] = (unsigned)(R * K + C) * 2u; }
    const size_t kstep = (size_t)(BK * 2);
    const size_t hstepA = (size_t)(2 * segstride) * K * 2, hstepB = (size_t)HALF * K * 2;
    const unsigned ldsw = (unsigned)wid * 1024u;
    const int aoff = lds_byte(wr * 64 + fr, fq * 8), boff = lds_byte(wc * 32 + fr, fq * 8);
#define PG8_SA(b, h) (((b) * 2 + (h)) * HTB)
#define PG8_SB(b, h) ((4 + (b) * 2 + (h)) * HTB)
#define PG8_STAGE(bufoff, gbase, voff) do { _Pragma("unroll") for (int _i = 0; _i < 2; ++_i) \
        __builtin_amdgcn_global_load_lds((const unsigned*)((const char*)(gbase) + (voff)[_i]), (LAS unsigned*)(lds + (bufoff) + ldsw + _i * 8192), 16, 0, 0); } while (0)
#define PG8_LDA(dst, b, h) do { _Pragma("unroll") for (int m = 0; m < 4; ++m) _Pragma("unroll") for (int k = 0; k < 2; ++k) dst[m][k] = *(const LAS bf16x8*)(lds + PG8_SA(b, h) + aoff + m * 2048 + k * 1024); } while (0)
#define PG8_LDB(dst, b, h) do { _Pragma("unroll") for (int n = 0; n < 2; ++n) _Pragma("unroll") for (int k = 0; k < 2; ++k) dst[n][k] = *(const LAS bf16x8*)(lds + PG8_SB(b, h) + boff + n * 2048 + k * 1024); } while (0)
#define PG8_MMA(ai, bj, At, Bt_) do { __builtin_amdgcn_s_setprio(1); _Pragma("unroll") for (int m = 0; m < 4; ++m) _Pragma("unroll") for (int n = 0; n < 2; ++n) _Pragma("unroll") for (int k = 0; k < 2; ++k) \
        acc[ai][bj][m][n] = __builtin_amdgcn_mfma_f32_16x16x32_bf16(Bt_[n][k], At[m][k], acc[ai][bj][m][n], 0, 0, 0); __builtin_amdgcn_s_setprio(0); } while (0)
#define PG8_WAIT_V(n) asm volatile("s_waitcnt vmcnt(" #n ")" ::: "memory")
#define PG8_WAIT_L(n) asm volatile("s_waitcnt lgkmcnt(" #n ")" ::: "memory")
#define PG8_BAR __builtin_amdgcn_s_barrier()
#define PG8_SCHED __builtin_amdgcn_sched_barrier(0)
    Unit cur, nxt; int ui = 0;
    if (!S.next(0, cur)) return;
    f32x4 acc[2][2][4][2];
#pragma unroll
    for (int a = 0; a < 2; ++a)
#pragma unroll
        for (int b = 0; b < 2; ++b)
#pragma unroll
            for (int m = 0; m < 4; ++m)
#pragma unroll
                for (int n = 0; n < 2; ++n) acc[a][b][m][n] = (f32x4){0.f, 0.f, 0.f, 0.f};
    bf16x8 At[4][2], B0[2][2], B1[2][2];
    E.prefetch(cur, lds, wid, lane);
    const char* cA = (const char*)A + ((size_t)E.arow(cur.pm) * K + cur.k0) * 2; const char* cB = (const char*)Bt + ((size_t)cur.pn * 256 * K + cur.k0) * 2;
    PG8_STAGE(PG8_SB(0, 0), cB, voffB); PG8_STAGE(PG8_SA(0, 0), cA, voffA); PG8_STAGE(PG8_SB(0, 1), cB + hstepB, voffB); PG8_STAGE(PG8_SA(0, 1), cA + hstepA, voffA);
    if (wr == 1) PG8_BAR;
    PG8_WAIT_V(4); PG8_BAR;
    PG8_STAGE(PG8_SB(1, 0), cB + kstep, voffB); PG8_STAGE(PG8_SA(1, 0), cA + kstep, voffA); PG8_STAGE(PG8_SB(1, 1), cB + hstepB + kstep, voffB);
    PG8_WAIT_V(6); PG8_BAR;
    for (;;) {
        const bool has_next = S.next(ui + 1, nxt);
        const char* nA = has_next ? (const char*)A + ((size_t)E.arow(nxt.pm) * K + nxt.k0) * 2 : cA; const char* nB = has_next ? (const char*)Bt + ((size_t)nxt.pn * 256 * K + nxt.k0) * 2 : cB;
        const int nt = cur.nt;
        for (int t = 0; t < nt; t += 2) {
            const bool last = (t == nt - 2);
            const char* a1 = cA + (size_t)(t + 1) * kstep;
            const char* a2 = last ? nA : cA + (size_t)(t + 2) * kstep; const char* b2 = last ? nB : cB + (size_t)(t + 2) * kstep;
            const char* a3 = a2 + kstep; const char* b3 = b2 + kstep;
            PG8_LDB(B0, 0, 0); PG8_SCHED; PG8_LDA(At, 0, 0); PG8_STAGE(PG8_SA(1, 1), a1 + hstepA, voffA);
            PG8_WAIT_L(8); PG8_BAR; PG8_WAIT_L(0); PG8_MMA(0, 0, At, B0); PG8_BAR; PG8_SCHED;
            PG8_LDB(B1, 0, 1); PG8_STAGE(PG8_SB(0, 0), b2, voffB);
            PG8_BAR; PG8_WAIT_L(0); PG8_MMA(0, 1, At, B1); PG8_BAR;
            PG8_LDA(At, 0, 1); PG8_STAGE(PG8_SA(0, 0), a2, voffA);
            PG8_BAR; PG8_WAIT_L(0); PG8_MMA(1, 0, At, B0); PG8_BAR; PG8_SCHED;
            PG8_STAGE(PG8_SB(0, 1), b2 + hstepB, voffB);
            PG8_WAIT_V(6); PG8_BAR; PG8_MMA(1, 1, At, B1); PG8_BAR;
            PG8_LDB(B0, 1, 0); PG8_SCHED; PG8_LDA(At, 1, 0); PG8_STAGE(PG8_SA(0, 1), a2 + hstepA, voffA);
            PG8_WAIT_L(8); PG8_BAR; PG8_WAIT_L(0); PG8_MMA(0, 0, At, B0); PG8_BAR; PG8_SCHED;
            PG8_LDB(B1, 1, 1); PG8_STAGE(PG8_SB(1, 0), b3, voffB);
            PG8_BAR; PG8_WAIT_L(0); PG8_MMA(0, 1, At, B1); PG8_BAR;
            PG8_LDA(At, 1, 1); PG8_STAGE(PG8_SA(1, 0), a3, voffA);
            PG8_BAR; PG8_WAIT_L(0); PG8_MMA(1, 0, At, B0); PG8_BAR; PG8_SCHED;
            PG8_STAGE(PG8_SB(1, 1), b3 + hstepB, voffB);
            PG8_WAIT_V(6); PG8_BAR; PG8_MMA(1, 1, At, B1); PG8_BAR;
        }
        E(acc, cur, wr, wc, fr, fq, lds, wid);
        if (!has_next) break;
        E.prefetch(nxt, lds, wid, lane);
#pragma unroll
        for (int a = 0; a < 2; ++a)
#pragma unroll
            for (int b = 0; b < 2; ++b)
#pragma unroll
                for (int m = 0; m < 4; ++m)
#pragma unroll
                    for (int n = 0; n < 2; ++n) acc[a][b][m][n] = (f32x4){0.f, 0.f, 0.f, 0.f};
        cur = nxt; cA = nA; cB = nB; ++ui;
    }
    PG8_WAIT_V(0);
    if (wr == 0) PG8_BAR;
    PG8_BAR;
#undef PG8_SA
#undef PG8_SB
#undef PG8_STAGE
#undef PG8_LDA
#undef PG8_LDB
#undef PG8_MMA
#undef PG8_WAIT_V
#undef PG8_WAIT_L
#undef PG8_BAR
#undef PG8_SCHED
}

typedef f32x4 Acc8[2][2][4][2];

struct EpiInproj {
    const Params* p; int l;
    __device__ __forceinline__ int arow(int pm) const { return pm < 64 ? 1 + 256 * pm : CTXB + 1; }
    __device__ __forceinline__ void prefetch(const Unit&, LAS unsigned char*, int, int) const {}
    __device__ __forceinline__ void operator()(const Acc8& acc, const Unit& u, int wr, int wc, int fr, int fq, LAS unsigned char*, int) const {
        bf16_t* P = (bf16_t*)(p->ws + OFF_P);
        const float* rope = (const float*)(p->ws + OFF_ROPE);
        const int orow = u.pm * 256 + wr * 64 + fr;
#pragma unroll
        for (int bj = 0; bj < 2; ++bj) {
            const int cb = u.pn * 256 + bj * 128 + wc * 32;
            if (cb >= IN_DIM) continue;
            if ((cb >= C_NV && cb < C_RQ) || (cb >= C_RV && cb < C_GT)) {
                bf16_t* vt = (bf16_t*)(p->ws + (cb >= C_RV ? OFF_RVT : OFF_NVT));
                const int c0 = cb - (cb >= C_RV ? C_RV : C_NV) + fq * 4;
#pragma unroll
                for (int ai = 0; ai < 2; ++ai)
#pragma unroll
                    for (int m = 0; m < 4; ++m) {
                        const int row = orow + ai * 128 + m * 16;
#pragma unroll
                        for (int n = 0; n < 2; ++n)
#pragma unroll
                            for (int j = 0; j < 4; ++j) vt[(size_t)(c0 + n * 16 + j) * MT + row] = (bf16_t)(pack_bf16(acc[ai][bj][m][n][j], 0.f) & 0xffffu);
                    }
            } else if (cb >= C_RQ && cb < C_RV) {
                const bool is_rk = cb >= C_RK;
                const int hh = (cb - (is_rk ? C_RK : C_RQ)) >> 6;
                const bool colpart = (cb & 32) != 0;
                const float lgf = p->dec_f[l * 6 + hh], lgb = p->dec_b[l * 6 + hh];
                bf16_t* kf = (bf16_t*)(p->ws + OFF_RKF);
                bf16_t* kb = (bf16_t*)(p->ws + OFF_RKB);
                const float sc = is_rk ? 0.125f : 1.f;
#pragma unroll
                for (int ai = 0; ai < 2; ++ai) {
                    f32x4 tcs[4], tsn[4];
#pragma unroll
                    for (int m = 0; m < 4; ++m) {
                        const int row = orow + ai * 128 + m * 16, pos = row < LAT ? (colpart ? (row & 63) : (row >> 6)) : 0;
                        tcs[m] = *(const f32x4*)(rope + pos * 16 + fq * 4); tsn[m] = *(const f32x4*)(rope + 4096 + pos * 16 + fq * 4);
                    }
                    PIN8(tcs[0], tcs[1], tcs[2], tcs[3], tsn[0], tsn[1], tsn[2], tsn[3]);
#pragma unroll
                    for (int m = 0; m < 4; ++m) {
                        const int row = orow + ai * 128 + m * 16;
                        f32x4 v0 = acc[ai][bj][m][0], v1 = acc[ai][bj][m][1];
                        if (row < LAT) {
                            const f32x4 cs = tcs[m], sn = tsn[m];
                            const f32x4 o0 = v0 * cs - v1 * sn, o1 = v0 * sn + v1 * cs;
                            v0 = o0; v1 = o1;
                        }
                        v0 *= sc; v1 *= sc;
                        bf16_t* pr_ = P + (size_t)row * IN_DIM + cb + fq * 4;
                        *(uint2*)(pr_) = pack4(v0[0], v0[1], v0[2], v0[3]);
                        *(uint2*)(pr_ + 16) = pack4(v1[0], v1[1], v1[2], v1[3]);
                        if (is_rk) {
                            const int c = row & 127;
                            const float df = __expf((float)(127 - c) * lgf), db = __expf((float)c * lgb);
                            const int rb = (cb - C_RK) + fq * 4;
#pragma unroll
                            for (int j = 0; j < 4; ++j) {
                                const size_t o0 = (size_t)(rb + j) * MT + row, o1 = (size_t)(rb + 16 + j) * MT + row;
                                kf[o0] = (bf16_t)(pack_bf16(v0[j] * df, 0.f) & 0xffffu);
                                kb[o0] = (bf16_t)(pack_bf16(v0[j] * db, 0.f) & 0xffffu);
                                kf[o1] = (bf16_t)(pack_bf16(v1[j] * df, 0.f) & 0xffffu);
                                kb[o1] = (bf16_t)(pack_bf16(v1[j] * db, 0.f) & 0xffffu);
                            }
                        }
                    }
                }
            } else {
                const bool is_gate = cb >= C_GT, is_nq = cb >= C_NQ && cb < C_NK;
#pragma unroll
                for (int ai = 0; ai < 2; ++ai)
#pragma unroll
                    for (int m = 0; m < 4; ++m) {
                        const int row = orow + ai * 128 + m * 16;
#pragma unroll
                        for (int n = 0; n < 2; ++n) {
                            f32x4 v = acc[ai][bj][m][n];
                            if (is_nq) v *= 0.125f * 1.44269504f;
                            if (is_gate) { v[0] = silu_f(v[0]); v[1] = silu_f(v[1]); v[2] = silu_f(v[2]); v[3] = silu_f(v[3]); }
                            *(uint2*)(P + (size_t)row * IN_DIM + cb + n * 16 + fq * 4) = pack4(v[0], v[1], v[2], v[3]);
                        }
                    }
            }
        }
    }
};

struct EpiResid {
    float* h; float* part; const float* mod; bool a_is_ay; bool dry; const float* hsrc;
    __device__ __forceinline__ int arow(int pm) const { return a_is_ay ? (pm < 64 ? 1 + 256 * pm : CTXB + 1) : 256 * pm; }
    __device__ __forceinline__ void prefetch(const Unit&, LAS unsigned char*, int, int) const {}
    __device__ __forceinline__ void operator()(const Acc8& acc, const Unit& u, int wr, int wc, int fr, int fq, LAS unsigned char*, int) const {
        const bool split = u.pm >= 64;
        const float* gv = mod + (u.pm >= 64 ? 6144 : 0) + u.pn * 256 + wc * 32 + fq * 4;
        float* hb = h + (size_t)(u.pm * 256 + wr * 64 + fr) * D + u.pn * 256 + wc * 32 + fq * 4;
        const ptrdiff_t poff = split ? (part - h) + ((ptrdiff_t)(u.k0 >> 8) * 256 - LAT) * D : 0;
        const ptrdiff_t soff = hsrc - h;
#pragma unroll
        for (int bj = 0; bj < 2; ++bj) {
            const f32x4 g0 = *(const f32x4*)(gv + bj * 128) * (dry ? 0.f : 1.f), g1 = *(const f32x4*)(gv + bj * 128 + 16) * (dry ? 0.f : 1.f);
            if (split) {
#pragma unroll
                for (int ai = 0; ai < 2; ++ai)
#pragma unroll
                    for (int m = 0; m < 4; ++m) {
                        float* q = hb + (size_t)(ai * 128 + m * 16) * D + bj * 128 + poff;
                        *(f32x4*)q = g0 * acc[ai][bj][m][0];
                        *(f32x4*)(q + 16) = g1 * acc[ai][bj][m][1];
                    }
            } else {
                f32x4 hv[2][4][2];
#pragma unroll
                for (int ai = 0; ai < 2; ++ai)
#pragma unroll
                    for (int m = 0; m < 4; ++m) {
                        const float* q = hb + (size_t)(ai * 128 + m * 16) * D + bj * 128 + soff;
                        hv[ai][m][0] = *(const f32x4*)q; hv[ai][m][1] = *(const f32x4*)(q + 16);
                    }
                PIN8(hv[0][0][0], hv[0][0][1], hv[0][1][0], hv[0][1][1], hv[0][2][0], hv[0][2][1], hv[0][3][0], hv[0][3][1]);
                PIN8(hv[1][0][0], hv[1][0][1], hv[1][1][0], hv[1][1][1], hv[1][2][0], hv[1][2][1], hv[1][3][0], hv[1][3][1]);
#pragma unroll
                for (int ai = 0; ai < 2; ++ai)
#pragma unroll
                    for (int m = 0; m < 4; ++m) {
                        float* q = hb + (size_t)(ai * 128 + m * 16) * D + bj * 128;
                        *(f32x4*)q = hv[ai][m][0] + g0 * acc[ai][bj][m][0];
                        *(f32x4*)(q + 16) = hv[ai][m][1] + g1 * acc[ai][bj][m][1];
                    }
            }
        }
    }
};

template <int CTRL> __device__ __forceinline__ float dpp_mov(float v) { return __int_as_float(__builtin_amdgcn_update_dpp(0, __float_as_int(v), CTRL, 0xf, 0xf, false)); }
struct EpiUp {
    const float* cw; const float* cbias; bf16_t* G;
    __device__ __forceinline__ int arow(int pm) const { return pm < 67 ? 248 * pm : CTXB + 248 * (pm - 67); }
    __device__ __forceinline__ void prefetch(const Unit& u, LAS unsigned char* lds, int wid, int lane) const {
        const int vec = lane >> 3, bj = (lane >> 2) & 1, wc = wid & 3;
        const int ff = 16 * (u.pn * 8 + bj * 4 + wc) + (lane & 3) * 4;
        const float* src_ = ((vec & 3) == 3 ? cbias : cw + (vec & 3) * NUP) + (vec >= 4 ? DFF : 0) + ff;
        __builtin_amdgcn_global_load_lds((const unsigned*)src_, (LAS unsigned*)(lds + CW_OFF + wid * 1024), 16, 0, 0);
    }
    __device__ __forceinline__ void operator()(const Acc8& acc, const Unit& u, int wr, int wc, int fr, int fq, LAS unsigned char* lds, int wid) const {
        const bool isctx = u.pm >= 67;
        const int t0 = 248 * (isctx ? u.pm - 67 : u.pm), slen = isctx ? NCTX : LAT, sbase = isctx ? LAT : 0;
#pragma unroll
        for (int bj = 0; bj < 2; ++bj) {
            const int ff = 16 * (u.pn * 8 + bj * 4 + wc) + fq * 4;
            LAS const unsigned char* cl = lds + CW_OFF + wid * 1024 + (bj * 4 + fq) * 16;
            const f32x4 wa0 = *(LAS const f32x4*)(cl), wa1 = *(LAS const f32x4*)(cl + 128), wa2 = *(LAS const f32x4*)(cl + 256), ba = *(LAS const f32x4*)(cl + 384);
            const f32x4 wb0 = *(LAS const f32x4*)(cl + 512), wb1 = *(LAS const f32x4*)(cl + 640), wb2 = *(LAS const f32x4*)(cl + 768), bb = *(LAS const f32x4*)(cl + 896);
#pragma unroll
            for (int ai = 0; ai < 2; ++ai) {
                const int tseg = t0 + 62 * (2 * ai + wr) - 1;
                float pa[4], pb[4], ca[4], cb2[4];
#pragma unroll
                for (int j = 0; j < 4; ++j) { pa[j] = 0.f; pb[j] = 0.f; ca[j] = dpp_mov<0x12F>(acc[ai][bj][0][0][j]); cb2[j] = dpp_mov<0x12F>(acc[ai][bj][0][1][j]); }
#pragma unroll
                for (int m = 0; m < 4; ++m) {
                    const int r = 16 * m + fr, tl = tseg + r;
                    float o[4];
#pragma unroll
                    for (int j = 0; j < 4; ++j) {
                        const float a_c = acc[ai][bj][m][0][j], b_c = acc[ai][bj][m][1][j];
                        const float a1 = dpp_mov<0x121>(a_c), b1 = dpp_mov<0x121>(b_c);
                        const float na = m < 3 ? dpp_mov<0x12F>(acc[ai][bj][m < 3 ? m + 1 : 3][0][j]) : 0.f;
                        const float nb = m < 3 ? dpp_mov<0x12F>(acc[ai][bj][m < 3 ? m + 1 : 3][1][j]) : 0.f;
                        const float ap = fr == 0 ? pa[j] : a1, bp = fr == 0 ? pb[j] : b1;
                        const float an = fr == 15 ? na : ca[j], bn = fr == 15 ? nb : cb2[j];
                        const float ua = wa0[j] * ap + wa1[j] * a_c + wa2[j] * an + ba[j];
                        const float ub = wb0[j] * bp + wb1[j] * b_c + wb2[j] * bn + bb[j];
                        o[j] = silu_f(ua) * ub;
                        pa[j] = a1; pb[j] = b1; ca[j] = na; cb2[j] = nb;
                    }
                    if (r >= 1 && r <= 62 && tl < slen) *(uint2*)(G + (size_t)(sbase + tl) * DFF + ff) = pack4(o[0], o[1], o[2], o[3]);
                }
            }
        }
    }
};

__device__ __forceinline__ void phase_inproj(const Params& p, int l, unsigned char* lds) {
    StaticOrder S; S.init(65, IN_PAD / 256, D, gridDim.x, blockIdx.x);
    EpiInproj E; E.p = &p; E.l = l;
    gemm8((LAS unsigned char*)lds, (const bf16_t*)(p.ws + OFF_AY), 64, (const bf16_t*)(p.ws + OFF_WT) + (size_t)l * WT_LAYER + WT_IN, D, S, E);
    const int nfourth = 65 * (IN_PAD / 256) - 3 * (int)gridDim.x;
    if (l + 1 < DEPTH && nfourth > 0 && nfourth < (int)gridDim.x && (int)blockIdx.x >= nfourth) {
        const int tid_all = opaque_tid(), half = tid_all >> 8, tid = tid_all & 255;
        float* cl = (float*)lds + half * 8192;
        __syncthreads();
        for (int it0 = ((int)blockIdx.x - nfourth) * 2; it0 < 1408; it0 += ((int)gridDim.x - nfourth) * 2) conv_layer_item(p, l + 1, 992 + it0 + half, cl, tid);
    } else if (l + 1 < DEPTH && !(nfourth > 0 && nfourth < (int)gridDim.x)) {
        const int tid_all = opaque_tid(), half = tid_all >> 8, tid = tid_all & 255;
        float* cl = (float*)lds + half * 8192;
        __syncthreads();
        for (int it0 = (int)blockIdx.x * 2; it0 < 1408; it0 += (int)gridDim.x * 2) conv_layer_item(p, l + 1, 992 + it0 + half, cl, tid);
    }
}
__device__ __forceinline__ void phase_resid(const Params& p, int l, bool a_is_ay, const bf16_t* A, const bf16_t* Bt, int K, int gate_idx, int mtiles, unsigned char* lds) {
    StaticOrder S; S.init(64, 4, K, gridDim.x, blockIdx.x);
    if (mtiles > 64) S.split_extra(64, 4);
    EpiResid E; E.h = (float*)(p.ws + OFF_H); E.part = (float*)(p.ws + OFF_PART); E.mod = (const float*)(p.ws + OFF_MOD) + (size_t)l * 2 * 6144 + gate_idx * D; E.a_is_ay = a_is_ay;
    E.hsrc = (l == 0 && a_is_ay) ? p.x : (const float*)E.h;
    E.dry = false;
#if PROBE_DUP == 5 || PROBE_DUP == 8
    E.dry = (K == (PROBE_DUP == 5 ? D : DFF));
    if (E.dry) { gemm8((LAS unsigned char*)lds, A, 64, Bt, K, S, E); E.dry = false; __syncthreads(); }
#endif
    gemm8((LAS unsigned char*)lds, A, 64, Bt, K, S, E);
}
__device__ __forceinline__ void phase_up(const Params& p, int l, bool with_ctx, unsigned char* lds) {
    StaticOrder S; S.init(with_ctx ? 69 : 67, NUP / 256, D, gridDim.x, blockIdx.x);
    EpiUp E; E.cw = p.conv_w + (size_t)l * 3 * NUP; E.cbias = p.conv_b + (size_t)l * NUP; E.G = (bf16_t*)(p.ws + OFF_P);
    gemm8((LAS unsigned char*)lds, (const bf16_t*)(p.ws + OFF_AY), 62, (const bf16_t*)(p.ws + OFF_WT) + (size_t)l * WT_LAYER + WT_UP, D, S, E);
}

__device__ void pool_item(const Params& p, int l, int item, unsigned char* lds, int tid) {
    const int g = item & 3, tt = item >> 2;
    const int t0 = tt * 64;
    const int s0 = t0 < LAT ? 0 : LAT, s1 = t0 < LAT ? LAT : MT;
    const bf16_t* P = (const bf16_t*)(p.ws + OFF_P);
    bf16_t* Y = (bf16_t*)(p.ws + OFF_AY);
    float* pin = (float*)lds;
    bf16_t* dif = (bf16_t*)(lds + 20800);
    bf16_t* wT = (bf16_t*)(lds + 20800 + 9216);
    const float* wg = p.pool_w + ((size_t)l * 4 + g) * 4096;
    {
        typedef unsigned u32x4 __attribute__((ext_vector_type(4)));
        u32x4 pu[3];
        f32x4 w4[4];
#pragma unroll
        for (int k = 0; k < 3; ++k) {
            const int i = tid + 256 * k, rr = (i < 640 ? i : tid) >> 3, c8 = (i & 7) * 8;
            int tok = t0 - 8 + rr;
            tok = tok < s0 ? s0 : (tok >= s1 ? s1 - 1 : tok);
            pu[k] = *(const u32x4*)(P + (size_t)tok * IN_DIM + C_POOL + g * 64 + c8);
        }
#pragma unroll
        for (int k = 0; k < 4; ++k) w4[k] = *(const f32x4*)(wg + ((tid + 256 * k) >> 4) * 64 + ((tid + 256 * k) & 15) * 4);
        asm volatile("" : "+v"(pu[0]), "+v"(pu[1]), "+v"(pu[2]), "+v"(w4[0]), "+v"(w4[1]), "+v"(w4[2]), "+v"(w4[3]) :: "memory");
#pragma unroll
        for (int k = 0; k < 3; ++k) {
            const int i = tid + 256 * k;
            if (i < 640) {
                float* d = pin + (i >> 3) * 65 + (i & 7) * 8;
                d[0] = bf2f(pu[k][0] & 0xffffu); d[1] = bf2f(pu[k][0] >> 16); d[2] = bf2f(pu[k][1] & 0xffffu); d[3] = bf2f(pu[k][1] >> 16);
                d[4] = bf2f(pu[k][2] & 0xffffu); d[5] = bf2f(pu[k][2] >> 16); d[6] = bf2f(pu[k][3] & 0xffffu); d[7] = bf2f(pu[k][3] >> 16);
            }
        }
#pragma unroll
        for (int k = 0; k < 4; ++k) {
            const int i = tid + 256 * k, c = i >> 4, d4 = (i & 15) * 4;
            wT[(d4 + 0) * 72 + c] = (bf16_t)(pack_bf16(w4[k][0], 0.f) & 0xffffu);
            wT[(d4 + 1) * 72 + c] = (bf16_t)(pack_bf16(w4[k][1], 0.f) & 0xffffu);
            wT[(d4 + 2) * 72 + c] = (bf16_t)(pack_bf16(w4[k][2], 0.f) & 0xffffu);
            wT[(d4 + 3) * 72 + c] = (bf16_t)(pack_bf16(w4[k][3], 0.f) & 0xffffu);
        }
    }
    __syncthreads();
    {
        const int c = tid & 63, tq = tid >> 6, win = 2 << g;
        int t = t0 + tq * 16;
        int lo = t - win / 2, hi = lo + win;
        lo = lo < s0 ? s0 : lo;
        hi = hi > s1 ? s1 : hi;
        float s = 0.f;
        for (int u = lo; u < hi; ++u) s += pin[(u - t0 + 8) * 65 + c];
#pragma unroll 4
        for (int k = 0; k < 16; ++k) {
            dif[(tq * 16 + k) * 72 + c] = (bf16_t)(pack_bf16(s * __builtin_amdgcn_rcpf((float)(hi - lo)) - pin[(t - t0 + 8) * 65 + c], 0.f) & 0xffffu);
            ++t;
            int nlo = t - win / 2, nhi = nlo + win;
            nlo = nlo < s0 ? s0 : nlo;
            nhi = nhi > s1 ? s1 : nhi;
            if (nhi > hi) s += pin[(nhi - 1 - t0 + 8) * 65 + c];
            if (nlo > lo) s -= pin[(lo - t0 + 8) * 65 + c];
            lo = nlo; hi = nhi;
        }
    }
    __syncthreads();
    {
        const int lane = tid & 63, w = tid >> 6, fr = lane & 15, fq = lane >> 4;
        f32x4 acc[4];
#pragma unroll
        for (int dt = 0; dt < 4; ++dt) acc[dt] = (f32x4){0.f, 0.f, 0.f, 0.f};
#pragma unroll
        for (int ks = 0; ks < 2; ++ks) {
            const bf16x8 yf = *(const bf16x8*)(dif + (w * 16 + fr) * 72 + ks * 32 + fq * 8);
#pragma unroll
            for (int dt = 0; dt < 4; ++dt) {
                const bf16x8 xf = *(const bf16x8*)(wT + (dt * 16 + fr) * 72 + ks * 32 + fq * 8);
                acc[dt] = mfma16(xf, yf, acc[dt]);
            }
        }
        const float* sc = p.pool_scale + (size_t)l * 256 + g * 64;
#pragma unroll
        for (int dt = 0; dt < 4; ++dt) {
            const f32x4 s4 = *(const f32x4*)(sc + dt * 16 + fq * 4);
            *(uint2*)(Y + (size_t)brow(t0 + w * 16 + fr) * D + g * 64 + dt * 16 + fq * 4) =
                pack4(acc[dt][0] * s4[0], acc[dt][1] * s4[1], acc[dt][2] * s4[2], acc[dt][3] * s4[3]);
        }
    }
    __syncthreads();
}

__device__ void na_item(const Params& p, int item, const float* rpb  ) {
    const int lane = opaque_tid() & 63, fr = lane & 15, fq = lane >> 4;
    const bf16_t* P = (const bf16_t*)(p.ws + OFF_P);
    const bf16_t* NVt = (const bf16_t*)(p.ws + OFF_NVT);
    bf16_t* Y = (bf16_t*)(p.ws + OFF_AY);
    int h, q0, r = 0, n = 0, rs = 0, cs = 0, nloc;
    if (item < 6144) {
        h = item % 6;
        const int rn = item / 6;
        n = rn & 3; r = rn >> 2;
        q0 = r * 64 + n * 16;
        rs = r - 4; rs = rs < 0 ? 0 : (rs > 248 ? 248 : rs);
        cs = n * 16 - 8; cs = cs < 0 ? 0 : (cs > 32 ? 32 : cs);
        nloc = 8;
    } else {
        const int ci = item - 6144;
        h = ci % 6;
        q0 = LAT + (ci / 6) * 16;
        nloc = 0;
    }
    bf16x8 qf[2];
#pragma unroll
    for (int ks = 0; ks < 2; ++ks) qf[ks] = *(const bf16x8*)(P + (size_t)(q0 + fr) * IN_DIM + C_NQ + h * 64 + ks * 32 + fq * 8);
    f32x4 o[4];
#pragma unroll
    for (int dt = 0; dt < 4; ++dt) o[dt] = (f32x4){0.f, 0.f, 0.f, 0.f};
    float m = -1e30f, lsum = 0.f;
    const int qc = n * 16 + fr;
    int wsn = qc - 8; wsn = wsn < 0 ? 0 : (wsn > 48 ? 48 : wsn);
    const int nsteps = nloc + 8;
#pragma unroll 1
    for (int s = 0; s < nsteps; ++s) {
        const bool loc = s < nloc;
        const int tb = loc ? (rs + s) * 64 + cs : LAT + (s - nloc) * 32;
        f32x4 st[2];
#pragma unroll
        for (int kt = 0; kt < 2; ++kt) {
            const bf16_t* kp = P + (size_t)(tb + kt * 16 + fr) * IN_DIM + C_NK + h * 64 + fq * 8;
            const bf16x8 k0 = *(const bf16x8*)kp, k1 = *(const bf16x8*)(kp + 32);
            st[kt] = mfma16(k0, qf[0], (f32x4){0.f, 0.f, 0.f, 0.f});
            st[kt] = mfma16(k1, qf[1], st[kt]);
        }
        if (loc) {
            const float* rb = rpb + (h * 15 + (rs + s - r + 7)) * 31;
#pragma unroll
            for (int kt = 0; kt < 2; ++kt)
#pragma unroll
                for (int j = 0; j < 4; ++j) {
                    const int kcol = cs + kt * 16 + fq * 4 + j;
                    const bool valid = kcol >= wsn && kcol < wsn + 16;
                    int dc = kcol - qc + 15; dc = dc < 0 ? 0 : (dc > 30 ? 30 : dc);
                    st[kt][j] = valid ? st[kt][j] + rb[dc] : -1e30f;
                }
        }
        float mx = fmaxf(fmaxf(fmaxf(st[0][0], st[0][1]), fmaxf(st[0][2], st[0][3])), fmaxf(fmaxf(st[1][0], st[1][1]), fmaxf(st[1][2], st[1][3])));
        mx = fmaxf(mx, __shfl_xor(mx, 16));
        mx = fmaxf(mx, __shfl_xor(mx, 32));
        const float mn = fmaxf(m, mx);
        const float alpha = __expf(m - mn);
        m = mn;
        float pv[8], ps = 0.f;
#pragma unroll
        for (int kt = 0; kt < 2; ++kt)
#pragma unroll
            for (int j = 0; j < 4; ++j) { pv[kt * 4 + j] = __expf(st[kt][j] - mn); ps += pv[kt * 4 + j]; }
        lsum = lsum * alpha + ps;
        const uint4 pu = make_uint4(pack_bf16(pv[0], pv[1]), pack_bf16(pv[2], pv[3]), pack_bf16(pv[4], pv[5]), pack_bf16(pv[6], pv[7]));
        const bf16x8 pf = *reinterpret_cast<const bf16x8*>(&pu);
#pragma unroll
        for (int dt = 0; dt < 4; ++dt) {
            const bf16_t* vp = NVt + (size_t)(h * 64 + dt * 16 + fr) * MT + tb + fq * 4;
            const bf16x8 vf = mk8(*(const uint2*)vp, *(const uint2*)(vp + 16));
            o[dt] *= alpha;
            o[dt] = mfma16(vf, pf, o[dt]);
        }
    }
    lsum += __shfl_xor(lsum, 16);
    lsum += __shfl_xor(lsum, 32);
    const float il = 1.f / lsum;
#pragma unroll
    for (int dt = 0; dt < 4; ++dt)
        *(uint2*)(Y + (size_t)brow(q0 + fr) * D + 256 + h * 64 + dt * 16 + fq * 4) = pack4(o[dt][0] * il, o[dt][1] * il, o[dt][2] * il, o[dt][3] * il);
}

constexpr int NA_CK = 0, NA_CV = 32768, NA_RING = 65536, NA_RPB = 131072;
struct NaState { f32x4 o[4]; float m, l; bf16x8 q[2]; };

template <bool LOC>
__device__ __forceinline__ void na_step_lds(NaState& s, LAS const unsigned char* kbase, int key0, LAS const unsigned char* vbase, int vstride, int tok0,
                                            LAS const float* rb, int cs, int qc, int wsn, int fr, int fq) {
    f32x4 st[2];
#pragma unroll
    for (int kt = 0; kt < 2; ++kt) {
        const int kk = key0 + 8 * (fr >> 2) + 4 * kt + (fr & 3);
        LAS const unsigned char* ka = kbase + kk * 128;
        const bf16x8 k0 = *(LAS const bf16x8*)(ka + ((fq ^ (kk & 7)) << 4));
        const bf16x8 k1 = *(LAS const bf16x8*)(ka + (((4 + fq) ^ (kk & 7)) << 4));
        st[kt] = mfma16(k0, s.q[0], (f32x4){0.f, 0.f, 0.f, 0.f});
        st[kt] = mfma16(k1, s.q[1], st[kt]);
    }
    if (LOC) {
#pragma unroll
        for (int kt = 0; kt < 2; ++kt)
#pragma unroll
            for (int j = 0; j < 4; ++j) {
                const int kcol = cs + 8 * fq + 4 * kt + j;
                const bool valid = kcol >= wsn && kcol < wsn + 16;
                int dc = kcol - qc + 15; dc = dc < 0 ? 0 : (dc > 30 ? 30 : dc);
                const float bias = rb[dc];
                st[kt][j] = valid ? st[kt][j] + bias : -1e30f;
            }
    }
    float mx = fmaxf(fmaxf(fmaxf(st[0][0], st[0][1]), fmaxf(st[0][2], st[0][3])), fmaxf(fmaxf(st[1][0], st[1][1]), fmaxf(st[1][2], st[1][3])));
    mx = fmaxf(mx, __shfl_xor(mx, 16));
    mx = fmaxf(mx, __shfl_xor(mx, 32));
    const float mn = fmaxf(s.m, mx);
    const float alpha = __builtin_amdgcn_exp2f(s.m - mn);
    s.m = mn;
    float pv[8], ps = 0.f;
#pragma unroll
    for (int kt = 0; kt < 2; ++kt)
#pragma unroll
        for (int j = 0; j < 4; ++j) { pv[kt * 4 + j] = __builtin_amdgcn_exp2f(st[kt][j] - mn); ps += pv[kt * 4 + j]; }
    s.l = s.l * alpha + ps;
    const uint4 pu = make_uint4(pack_bf16(pv[0], pv[1]), pack_bf16(pv[2], pv[3]), pack_bf16(pv[4], pv[5]), pack_bf16(pv[6], pv[7]));
    const bf16x8 pf = *reinterpret_cast<const bf16x8*>(&pu);
    const int chunk = (tok0 >> 3) + fq;
#pragma unroll
    for (int dt = 0; dt < 4; ++dt) {
        const int d = dt * 16 + fr;
        const bf16x8 vf = *(LAS const bf16x8*)(vbase + d * vstride + ((chunk ^ (d & 7)) << 4));
        s.o[dt] *= alpha;
        s.o[dt] = mfma16(vf, pf, s.o[dt]);
    }
}

__device__ __forceinline__ void phase_na(const Params& p, int l, bool with_ctx, unsigned char* lds_g) {
    LAS unsigned char* lds = (LAS unsigned char*)lds_g;
    const int tid = opaque_tid(), wave = __builtin_amdgcn_readfirstlane(tid >> 6), lane = tid & 63, fr = lane & 15, fq = lane >> 4;
    const int G = gridDim.x, b = blockIdx.x;
    const int h = b % 6, idx = b / 6, nblk = (G - h + 5) / 6;
    const int r_lo = idx * 256 / nblk, r_hi = (idx + 1) * 256 / nblk, nst = (r_hi - r_lo) * 4;
    const bf16_t* P = (const bf16_t*)(p.ws + OFF_P);
    const bf16_t* Kg = P + C_NK + h * 64;
    const bf16_t* Vg = (const bf16_t*)(p.ws + OFF_NVT) + (size_t)(h * 64) * MT;
    bf16_t* Y = (bf16_t*)(p.ws + OFF_AY);
    LAS float* rpb = (LAS float*)(lds + NA_RPB);
    for (int i = tid; i < 465; i += NT) rpb[i] = p.na_rpb[((size_t)l * 6 + h) * 465 + i] * 1.44269504f;
#define NA_GLDS(gptr, loff) __builtin_amdgcn_global_load_lds((const unsigned*)(gptr), (LAS unsigned*)(lds + (loff)), 16, 0, 0)
    const bool has_cx = with_ctx && idx < 16;
    NaState st[4];
    int sr[4], snb[4];
    bool sv[4], sx[4];
#pragma unroll
    for (int si = 0; si < 4; ++si) {
        const int g = wave + 8 * si;
        sx[si] = has_cx && g == nst;
        sv[si] = g < nst || sx[si];
        sr[si] = r_lo + (g >> 2); snb[si] = g & 3;
        const int q0 = sx[si] ? LAT + idx * 16 : (sv[si] ? sr[si] : r_lo) * 64 + snb[si] * 16;
#pragma unroll
        for (int ks = 0; ks < 2; ++ks) st[si].q[ks] = *(const bf16x8*)(P + (size_t)(q0 + fr) * IN_DIM + C_NQ + h * 64 + ks * 32 + fq * 8);
#pragma unroll
        for (int dt = 0; dt < 4; ++dt) st[si].o[dt] = (f32x4){0.f, 0.f, 0.f, 0.f};
        st[si].m = -1e30f; st[si].l = 0.f;
        asm volatile("" : "+v"(st[si].q[0]), "+v"(st[si].q[1]));
    }
#pragma unroll
    for (int i = 0; i < 4; ++i) {
        const int q = wave * 4 + i, s = q * 64 + lane, key = s >> 3, ch = (s & 7) ^ (key & 7);
        NA_GLDS(Kg + (size_t)(LAT + key) * IN_DIM + ch * 8, NA_CK + q * 1024);
    }
#pragma unroll
    for (int i = 0; i < 4; ++i) {
        const int q = wave * 4 + i, s = q * 64 + lane, d = s >> 5, ch = (s & 31) ^ (d & 7);
        NA_GLDS(Vg + (size_t)d * MT + LAT + ch * 8, NA_CV + q * 1024);
    }
    int kr_lo = r_lo - 4; kr_lo = kr_lo < 0 ? 0 : (kr_lo > 248 ? 248 : kr_lo);
    int kr_hi = r_hi - 1 - 4; kr_hi = (kr_hi < 0 ? 0 : (kr_hi > 248 ? 248 : kr_hi)) + 7;
    const int srow = wave * 64 + lane, scol = srow >> 3, sch = (srow & 7) ^ (scol & 7);
    const bf16_t* kst = Kg + (size_t)scol * IN_DIM + sch * 8;
    const bf16_t* vst = Vg + (size_t)scol * MT + sch * 8;
#define NA_STAGE(kr_, slot_) do { const int _kr = (kr_) > kr_hi ? kr_hi : (kr_); \
        NA_GLDS(kst + (size_t)_kr * 64 * IN_DIM, NA_RING + (slot_) * 16384 + wave * 1024); \
        NA_GLDS(vst + _kr * 64, NA_RING + (slot_) * 16384 + 8192 + wave * 1024); } while (0)
    NA_STAGE(kr_lo, 0); NA_STAGE(kr_lo + 1, 1); NA_STAGE(kr_lo + 2, 2);
    for (int kr = kr_lo; kr <= kr_hi; ++kr) {
        const int j = kr - kr_lo;
        asm volatile("s_waitcnt vmcnt(4)" ::: "memory");
        __builtin_amdgcn_s_barrier();
        asm volatile("" ::: "memory");
        NA_STAGE(kr + 3, (j + 3) & 3);
        LAS const unsigned char* kb = lds + NA_RING + (j & 3) * 16384;
        bool act[4];
#pragma unroll
        for (int si = 0; si < 4; ++si) {
            int rs = sr[si] - 4; rs = rs < 0 ? 0 : (rs > 248 ? 248 : rs);
            act[si] = sv[si] && !sx[si] && kr >= rs && kr < rs + 8;
        }
#define NA_LOC(si_) do { int cs = snb[si_] * 16 - 8; cs = cs < 0 ? 0 : (cs > 32 ? 32 : cs); const int qc = snb[si_] * 16 + fr; \
            int wsn = qc - 8; wsn = wsn < 0 ? 0 : (wsn > 48 ? 48 : wsn); \
            na_step_lds<true>(st[si_], kb, cs, kb + 8192, 128, cs, rpb + (kr - sr[si_] + 7) * 31, cs, qc, wsn, fr, fq); } while (0)
        if (act[0]) NA_LOC(0);
        if (act[1]) NA_LOC(1);
        if (act[2]) NA_LOC(2);
        if (act[3]) NA_LOC(3);
#undef NA_LOC
    }
    asm volatile("s_waitcnt vmcnt(0)" ::: "memory");
#define NA_CTX(si_, c_) na_step_lds<false>(st[si_], lds + NA_CK, (c_) * 32, lds + NA_CV, 512, (c_) * 32, rpb, 0, 0, 0, fr, fq)
    if (sv[0] && sv[1]) { for (int c = 0; c < 8; ++c) { NA_CTX(0, c); NA_CTX(1, c); } }
    else { if (sv[0]) for (int c = 0; c < 8; ++c) NA_CTX(0, c); if (sv[1]) for (int c = 0; c < 8; ++c) NA_CTX(1, c); }
    if (sv[2] && sv[3]) { for (int c = 0; c < 8; ++c) { NA_CTX(2, c); NA_CTX(3, c); } }
    else { if (sv[2]) for (int c = 0; c < 8; ++c) NA_CTX(2, c); if (sv[3]) for (int c = 0; c < 8; ++c) NA_CTX(3, c); }
#undef NA_CTX
#pragma unroll
    for (int si = 0; si < 4; ++si) {
        if (sv[si]) {
            float lsum = st[si].l;
            lsum += __shfl_xor(lsum, 16);
            lsum += __shfl_xor(lsum, 32);
            const float il = 1.f / lsum;
            const int q0 = sx[si] ? LAT + idx * 16 : sr[si] * 64 + snb[si] * 16;
#pragma unroll
            for (int dt = 0; dt < 4; ++dt)
                *(uint2*)(Y + (size_t)brow(q0 + fr) * D + 256 + h * 64 + dt * 16 + fq * 4) =
                    pack4(st[si].o[dt][0] * il, st[si].o[dt][1] * il, st[si].o[dt][2] * il, st[si].o[dt][3] * il);
        }
    }
#undef NA_STAGE
#undef NA_GLDS
    __syncthreads();
}

__device__ void retu_item(const Params& p, int item) {
    const int lane = opaque_tid() & 63, fr = lane & 15, fq = lane >> 4;
    const int dir = item & 1, ch_h = item >> 1, h = ch_h % 6, chunk = ch_h / 6;
    const bf16_t* Vt = (const bf16_t*)(p.ws + OFF_RVT) + (size_t)(h * 64) * MT + chunk * 128;
    const bf16_t* Kt = (const bf16_t*)(p.ws + (dir ? OFF_RKB : OFF_RKF)) + (size_t)(h * 64) * MT + chunk * 128;
    float* U = (float*)(p.ws + OFF_US) + ((size_t)(chunk * 2 + dir) * 6 + h) * 4096;
    f32x4 acc[4][4];
#pragma unroll
    for (int i = 0; i < 4; ++i)
#pragma unroll
        for (int j = 0; j < 4; ++j) acc[i][j] = (f32x4){0.f, 0.f, 0.f, 0.f};
    bf16x8 vf[4][4], kf[4][4];
#pragma unroll
    for (int ks = 0; ks < 4; ++ks)
#pragma unroll
        for (int t = 0; t < 4; ++t) {
            vf[ks][t] = *(const bf16x8*)(Vt + (size_t)(t * 16 + fr) * MT + ks * 32 + fq * 8);
            kf[ks][t] = *(const bf16x8*)(Kt + (size_t)(t * 16 + fr) * MT + ks * 32 + fq * 8);
        }
    PIN8(vf[0][0], vf[0][1], vf[0][2], vf[0][3], kf[0][0], kf[0][1], kf[0][2], kf[0][3]);
    PIN8(vf[1][0], vf[1][1], vf[1][2], vf[1][3], kf[1][0], kf[1][1], kf[1][2], kf[1][3]);
    PIN8(vf[2][0], vf[2][1], vf[2][2], vf[2][3], kf[2][0], kf[2][1], kf[2][2], kf[2][3]);
    PIN8(vf[3][0], vf[3][1], vf[3][2], vf[3][3], kf[3][0], kf[3][1], kf[3][2], kf[3][3]);
#pragma unroll
    for (int ks = 0; ks < 4; ++ks)
#pragma unroll
        for (int et = 0; et < 4; ++et)
#pragma unroll
            for (int dt = 0; dt < 4; ++dt) acc[et][dt] = mfma16(vf[ks][et], kf[ks][dt], acc[et][dt]);
#pragma unroll
    for (int et = 0; et < 4; ++et)
#pragma unroll
        for (int dt = 0; dt < 4; ++dt)
#pragma unroll
            for (int j = 0; j < 4; ++j) U[(et * 16 + fq * 4 + j) * 64 + dt * 16 + fr] = acc[et][dt][j];
}

__device__ __forceinline__ void phase_scan(const Params& p, int l) {
    float* US = (float*)(p.ws + OFF_US);
    bf16_t* S16 = (bf16_t*)(p.ws + OFF_RKF);
    for (int e = blockIdx.x * NT + opaque_tid(); e < 2 * 6 * 4096; e += gridDim.x * NT) {
        const int dir = e / 24576, rem = e % 24576, h = rem >> 12, ed = rem & 4095;
        const float lg = dir ? p.dec_b[l * 6 + h] : p.dec_f[l * 6 + h];
        const float cd = __expf(128.f * lg);
        float s = 0.f;
        for (int b = 0; b < 5; ++b) {
            float u[26];
            size_t idx[26];
#pragma unroll
            for (int i = 0; i < 26; ++i) {
                const int q = b * 26 + i;
                int chunk;
                if (dir == 0) chunk = q < 2 ? 128 + q : q - 2;
                else chunk = q < 2 ? 129 - q : 129 - q;
                idx[i] = ((size_t)(chunk * 2 + dir) * 6 + h) * 4096 + ed;
                u[i] = US[idx[i]];
            }
#pragma unroll
            for (int i = 0; i < 26; ++i) {
                S16[idx[i]] = (bf16_t)(pack_bf16(s, 0.f) & 0xffffu);
                s = s * cd + u[i];
            }
        }
    }
}

__device__ void reto_item(const Params& p, int l, int item) {
    const int lane = opaque_tid() & 63, fr = lane & 15, fq = lane >> 4;
    const int iq = item & 3, ch_h = item >> 2, h = ch_h % 6, chunk = ch_h / 6;
    const int tok0 = chunk * 128;
    const bf16_t* P = (const bf16_t*)(p.ws + OFF_P);
    const bf16_t* RVt = (const bf16_t*)(p.ws + OFF_RVT);
    const bf16_t* S16 = (const bf16_t*)(p.ws + OFF_RKF);
    bf16_t* Y = (bf16_t*)(p.ws + OFF_AY);
    const float lgf = p.dec_f[l * 6 + h] * 1.44269504f, lgb = p.dec_b[l * 6 + h] * 1.44269504f;
    bf16x8 qf[2][2], kf[4][2][2], vf[4][4];
#pragma unroll
    for (int it = 0; it < 2; ++it)
#pragma unroll
        for (int ks = 0; ks < 2; ++ks) qf[it][ks] = *(const bf16x8*)(P + (size_t)(tok0 + iq * 32 + it * 16 + fr) * IN_DIM + C_RQ + h * 64 + ks * 32 + fq * 8);
#pragma unroll
    for (int pp = 0; pp < 4; ++pp)
#pragma unroll
        for (int jj = 0; jj < 2; ++jj) {
            const bf16_t* kp = P + (size_t)(tok0 + pp * 32 + 8 * (fr >> 2) + 4 * jj + (fr & 3)) * IN_DIM + C_RK + h * 64 + fq * 8;
            kf[pp][jj][0] = *(const bf16x8*)kp; kf[pp][jj][1] = *(const bf16x8*)(kp + 32);
        }
#pragma unroll
    for (int pp = 0; pp < 2; ++pp)
#pragma unroll
        for (int et = 0; et < 4; ++et) vf[pp][et] = *(const bf16x8*)(RVt + (size_t)(h * 64 + et * 16 + fr) * MT + tok0 + pp * 32 + fq * 8);
    bf16x8 sf[2][4][2];
    PIN8(qf[0][0], qf[0][1], qf[1][0], qf[1][1], kf[0][0][0], kf[0][0][1], kf[0][1][0], kf[0][1][1]);
    PIN8(kf[1][0][0], kf[1][0][1], kf[1][1][0], kf[1][1][1], kf[2][0][0], kf[2][0][1], kf[2][1][0], kf[2][1][1]);
    PIN8(kf[3][0][0], kf[3][0][1], kf[3][1][0], kf[3][1][1], vf[0][0], vf[0][1], vf[0][2], vf[0][3]);
    asm volatile("" : "+v"(vf[1][0]), "+v"(vf[1][1]), "+v"(vf[1][2]), "+v"(vf[1][3]) :: "memory");
#pragma unroll
    for (int pp = 2; pp < 4; ++pp)
#pragma unroll
        for (int et = 0; et < 4; ++et) vf[pp][et] = *(const bf16x8*)(RVt + (size_t)(h * 64 + et * 16 + fr) * MT + tok0 + pp * 32 + fq * 8);
    uint2 gu[2][4];
    f32x4 gnv[4];
#pragma unroll
    for (int it = 0; it < 2; ++it)
#pragma unroll
        for (int et = 0; et < 4; ++et) gu[it][et] = *(const uint2*)(P + (size_t)(tok0 + iq * 32 + it * 16 + fr) * IN_DIM + C_GT + h * 64 + et * 16 + fq * 4);
#pragma unroll
    for (int et = 0; et < 4; ++et) gnv[et] = *(const f32x4*)(p.gn_g + (size_t)l * 384 + h * 64 + et * 16 + fq * 4);
    f32x4 y[4][2];
#pragma unroll
    for (int et = 0; et < 4; ++et)
#pragma unroll
        for (int it = 0; it < 2; ++it) y[et][it] = (f32x4){0.f, 0.f, 0.f, 0.f};
#pragma unroll
    for (int pp = 0; pp < 4; ++pp) {
        if (pp == 2) {
            PIN8(vf[2][0], vf[2][1], vf[2][2], vf[2][3], vf[3][0], vf[3][1], vf[3][2], vf[3][3]);
#pragma unroll
            for (int dir = 0; dir < 2; ++dir)
#pragma unroll
                for (int et = 0; et < 4; ++et)
#pragma unroll
                    for (int ks = 0; ks < 2; ++ks) sf[dir][et][ks] = *(const bf16x8*)(S16 + ((size_t)(chunk * 2 + dir) * 6 + h) * 4096 + (et * 16 + fr) * 64 + ks * 32 + fq * 8);
        }
        f32x4 a[2][2];
#pragma unroll
        for (int jj = 0; jj < 2; ++jj)
#pragma unroll
            for (int it = 0; it < 2; ++it) {
                a[jj][it] = mfma16(kf[pp][jj][0], qf[it][0], (f32x4){0.f, 0.f, 0.f, 0.f});
                a[jj][it] = mfma16(kf[pp][jj][1], qf[it][1], a[jj][it]);
            }
        bf16x8 bt[2];
#pragma unroll
        for (int it = 0; it < 2; ++it) {
            const int i = iq * 32 + it * 16 + fr;
            float pv[8];
#pragma unroll
            for (int jj = 0; jj < 2; ++jj)
#pragma unroll
                for (int rr = 0; rr < 4; ++rr) {
                    const int j = pp * 32 + fq * 8 + jj * 4 + rr;
                    const int df = i - j;
                    const float dcy = (df >= 0 ? __builtin_amdgcn_exp2f((float)df * lgf) : 0.f) + (df <= 0 ? __builtin_amdgcn_exp2f((float)(-df) * lgb) : 0.f);
                    pv[jj * 4 + rr] = a[jj][it][rr] * dcy;
                }
            const uint4 pu = make_uint4(pack_bf16(pv[0], pv[1]), pack_bf16(pv[2], pv[3]), pack_bf16(pv[4], pv[5]), pack_bf16(pv[6], pv[7]));
            bt[it] = *reinterpret_cast<const bf16x8*>(&pu);
        }
#pragma unroll
        for (int et = 0; et < 4; ++et)
#pragma unroll
            for (int it = 0; it < 2; ++it) y[et][it] = mfma16(vf[pp][et], bt[it], y[et][it]);
    }
    PIN8(sf[0][0][0], sf[0][0][1], sf[0][1][0], sf[0][1][1], sf[0][2][0], sf[0][2][1], sf[0][3][0], sf[0][3][1]);
    PIN8(sf[1][0][0], sf[1][0][1], sf[1][1][0], sf[1][1][1], sf[1][2][0], sf[1][2][1], sf[1][3][0], sf[1][3][1]);
    PIN8(gu[0][0], gu[0][1], gu[0][2], gu[0][3], gu[1][0], gu[1][1], gu[1][2], gu[1][3]);
    asm volatile("" : "+v"(gnv[0]), "+v"(gnv[1]), "+v"(gnv[2]), "+v"(gnv[3]) :: "memory");
#pragma unroll
    for (int dir = 0; dir < 2; ++dir) {
        f32x4 z[4][2];
#pragma unroll
        for (int et = 0; et < 4; ++et) {
            z[et][0] = (f32x4){0.f, 0.f, 0.f, 0.f};
            z[et][1] = (f32x4){0.f, 0.f, 0.f, 0.f};
#pragma unroll
            for (int ks = 0; ks < 2; ++ks) {
                z[et][0] = mfma16(sf[dir][et][ks], qf[0][ks], z[et][0]);
                z[et][1] = mfma16(sf[dir][et][ks], qf[1][ks], z[et][1]);
            }
        }
#pragma unroll
        for (int it = 0; it < 2; ++it) {
            const int ii = iq * 32 + it * 16 + fr;
            const float sc = dir == 0 ? __builtin_amdgcn_exp2f((float)(ii + 1) * lgf) : __builtin_amdgcn_exp2f((float)(128 - ii) * lgb);
#pragma unroll
            for (int et = 0; et < 4; ++et) y[et][it] += z[et][it] * sc;
        }
    }
#pragma unroll
    for (int it = 0; it < 2; ++it) {
        float s = 0.f;
#pragma unroll
        for (int et = 0; et < 4; ++et) s += y[et][it][0] + y[et][it][1] + y[et][it][2] + y[et][it][3];
        s += __shfl_xor(s, 16);
        s += __shfl_xor(s, 32);
        const float mu = s * (1.f / 64.f);
        float v = 0.f;
#pragma unroll
        for (int et = 0; et < 4; ++et)
#pragma unroll
            for (int j = 0; j < 4; ++j) { const float d = y[et][it][j] - mu; v += d * d; }
        v += __shfl_xor(v, 16);
        v += __shfl_xor(v, 32);
        const float rs = rsqrtf(v * (1.f / 64.f) + 1e-6f);
        const int tok = tok0 + iq * 32 + it * 16 + fr;
#pragma unroll
        for (int et = 0; et < 4; ++et) {
            const int e0 = et * 16 + fq * 4;
            const f32x4 gn = gnv[et];
            const float g0 = bf2f(gu[it][et].x & 0xffffu), g1 = bf2f(gu[it][et].x >> 16), g2 = bf2f(gu[it][et].y & 0xffffu), g3 = bf2f(gu[it][et].y >> 16);
            *(uint2*)(Y + (size_t)brow(tok) * D + 640 + h * 64 + e0) =
                pack4((y[et][it][0] - mu) * rs * gn[0] * g0, (y[et][it][1] - mu) * rs * gn[1] * g1, (y[et][it][2] - mu) * rs * gn[2] * g2,
                      (y[et][it][3] - mu) * rs * gn[3] * g3);
        }
    }
}

__device__ __forceinline__ void phase_mix1(const Params& p, int l, float* lds) {
    const int tid = opaque_tid(), wave = tid >> 6, half = tid >> 8;
    const bool with_ctx = l < DEPTH - 1;
    const int npool = (with_ctx ? MT : LAT) / 64 * 4;
    for (int rep = 0; rep < (PROBE_DUP == 12 ? 2 : 1); ++rep)
    for (int it0 = blockIdx.x * 2; it0 < npool; it0 += gridDim.x * 2) pool_item(p, l, it0 + half, (unsigned char*)lds + half * 40960, tid & 255);
    for (int rep = 0; rep < (PROBE_DUP == 11 ? 2 : 1); ++rep) phase_na(p, l, with_ctx, (unsigned char*)lds);
    const int gw = blockIdx.x * 8 + wave, nw = gridDim.x * 8;
    for (int rep = 0; rep < (PROBE_DUP == 13 ? 2 : 1); ++rep)
    for (int it = gw; it < NCHUNK * 6 * 2; it += nw) retu_item(p, it);
    __syncthreads();
}
__device__ __forceinline__ void phase_mix3(const Params& p, int l) {
    const int wave = opaque_tid() >> 6;
    const bool with_ctx = l < DEPTH - 1;
    const int n = (with_ctx ? NCHUNK : 128) * 6 * 4;
    for (int it = blockIdx.x * 8 + wave; it < n; it += gridDim.x * 8) reto_item(p, l, it);
}

__device__ void run_phase(const Params& p, int ph, unsigned char* lds) {
    if (ph == 0) { phase_prep(p, (float*)lds); return; }
    if (ph == NPHASE - 1) { phase_final(p); return; }
    const int l = (ph - 1) / 9, s = (ph - 1) % 9;
    const bool with_ctx = l < DEPTH - 1;
    const bf16_t* wl = (const bf16_t*)(p.ws + OFF_WT) + (size_t)l * WT_LAYER;
    switch (s) {
        case 1: phase_inproj(p, l, lds); break;
        case 2: phase_mix1(p, l, (float*)lds); break;
        case 3: phase_scan(p, l); break;
        case 4: phase_mix3(p, l); break;
        case 0:
        case 6: {
            const bool second = s == 6;
            phase_norm(p, l, (second ? p.norm2_g : p.norm1_g) + (size_t)l * D, second ? 3 : 0, (second && !with_ctx) ? LAT : MT, second ? 4 : (l > 0 ? 11 : 0));
            break;
        }
        case 7: phase_up(p, l, with_ctx, lds); break;
        case 5:
        case 8: {
            const bool down = s == 8;
            phase_resid(p, l, !down, (const bf16_t*)(p.ws + (down ? OFF_P : OFF_AY)), wl + (down ? WT_DOWN : WT_OUT), down ? DFF : D, down ? 5 : 2, with_ctx ? 65 : 64, lds);
            break;
        }
    }
}

__global__ void __launch_bounds__(512, 2) fwd_kernel(Params p) {
    extern __shared__ __attribute__((aligned(16))) unsigned char lds[];
    uint4& xb_words = *(uint4*)(lds + XB_OFF);
#if ONE_LAUNCH
    cg::grid_group grid = cg::this_grid();
    if (threadIdx.x == 0) xb_words = make_uint4(0u, 0u, 0u, 0u);
    __syncthreads();
    XcdBarrier xb = xcd_barrier_post((unsigned*)(p.ws + OFF_BAR), (volatile LAS unsigned*)&xb_words);
#endif
    int ph = p.ph_lo, rep = 0;
    while (ph < p.ph_hi) {
        run_phase(p, ph, lds);
        bool again = false;
#if PROBE_DUP >= 0 && PROBE_DUP < 10
        again = rep == 0 && ((PROBE_DUP == 9 && ph == 0) || (PROBE_DUP < 9 && ph > 0 && ph < NPHASE - 1 && (ph - 1) % 9 == PROBE_DUP));
#endif
        rep = again ? 1 : 0;
        if (!again) ++ph;
#if ONE_LAUNCH
        if (ph < p.ph_hi) {
            if (p.ph_hi > NPHASE) grid.sync();
            xcd_barrier(xb);
        }
#endif
    }
}

extern "C" void kernel_launch(void* const* d_in, const int* in_sizes, int n_in, void* d_out, int out_size, void* d_ws, size_t ws_size,
                              hipStream_t stream) {
    static int grid_blocks = 0;
    if (!grid_blocks) {
        int dev = 0, cus = 0, per_cu = 0;
        hipGetDevice(&dev);
        hipDeviceGetAttribute(&cus, hipDeviceAttributeMultiprocessorCount, dev);
        hipFuncSetAttribute((const void*)fwd_kernel, hipFuncAttributeMaxDynamicSharedMemorySize, LDS_BYTES);
        hipOccupancyMaxActiveBlocksPerMultiprocessor(&per_cu, (const void*)fwd_kernel, NT, LDS_BYTES);
        if (per_cu < 1) per_cu = 1;
        if (per_cu > 1) per_cu = 1;
        grid_blocks = cus * per_cu;
        if (ws_size < WS_END) fprintf(stderr, "kernel_launch: workspace too small: %zu < %zu\n", ws_size, (size_t)WS_END);
    }
    Params p{};
    const float** pf = (const float**)&p;
    for (int i = 0; i < 21; ++i) pf[i] = (const float*)d_in[i];
    p.out = (float*)d_out;
    p.ws = (unsigned char*)d_ws;
#if ONE_LAUNCH
    hipMemsetAsync((unsigned char*)d_ws + OFF_BAR, 0, 16384, stream);
    p.ph_lo = 0;
    p.ph_hi = NPHASE;
    void* args[] = {&p};
    hipError_t e = hipLaunchCooperativeKernel((const void*)fwd_kernel, dim3(grid_blocks), dim3(NT), args, LDS_BYTES, stream);
    if (e != hipSuccess) fprintf(stderr, "cooperative launch failed: %s (grid %d)\n", hipGetErrorString(e), grid_blocks);
#else
    for (int ph = 0; ph < NPHASE; ++ph) {
        p.ph_lo = ph;
        p.ph_hi = ph + 1;
        hipLaunchKernelGGL(fwd_kernel, dim3(grid_blocks), dim3(NT), LDS_BYTES, stream, p);
    }
#endif
}
```
